# Optimizing an MI355X kernel written in HIP

```python
import math
import jax, jax.numpy as jnp
from jax import lax
import numpy as np

D_MODEL = 1024
BATCH = 2
SEQ = 8192
DEPTH = 2

W_SSM = 256
W_RWKV = 256
W_CONV = 256
W_FFT = 256
D_MIX = W_SSM + W_RWKV + W_CONV + W_FFT
D_IN_PROJ = W_SSM + 3 * W_RWKV + 3 * W_CONV + W_FFT
SSM_CH = 16
SSM_GROUPS = W_SSM // SSM_CH
SSM_STATE = 64
DT_MIN = 1e-3
DT_MAX = 1e-1
RWKV_HEAD = 64
RWKV_HEADS = W_RWKV // RWKV_HEAD
DECAY_LORA = 64
AAA_LORA = 64
GATE_LORA = 160
RWKV_DECAY_SCALE = math.exp(-0.5)
RWKV_GN_EPS = 64e-5
CONV_WIDTH = 3
FFT_GROUPS = 4
FFT_CH = W_FFT // FFT_GROUPS
D_FF = int(math.ceil(8 * D_MODEL / 3 / 256)) * 256
DEEPNORM_ALPHA = (2 * DEPTH) ** 0.25
DEEPNORM_BETA = (8 * DEPTH) ** -0.25
LN_EPS = 1e-5

kernel_name = 'hybrid_parallel_head_encoder'


def _layer_norm(x, g, b):
    xf = x.astype(jnp.float32)
    mu = jnp.mean(xf, -1, keepdims=True)
    var = jnp.mean(jnp.square(xf - mu), -1, keepdims=True)
    return ((xf - mu) * lax.rsqrt(var + LN_EPS) * g + b).astype(x.dtype)


def _shift_prev(z):
    return jnp.pad(z[:, :-1], ((0, 0), (1, 0), (0, 0)))


def _shift_next(z):
    return jnp.pad(z[:, 1:], ((0, 0), (0, 1), (0, 0)))


def _flip_backward(z):
    return jnp.concatenate([z[:1], jnp.flip(z[1:], axis=2)], axis=0)


def _cplx_affine_combine(earlier, later):
    a1r, a1i, b1r, b1i = earlier
    a2r, a2i, b2r, b2i = later
    return (a2r * a1r - a2i * a1i,
            a2r * a1i + a2i * a1r,
            a2r * b1r - a2i * b1i + b2r,
            a2r * b1i + a2i * b1r + b2i)


def _s5_mixer(u, lam_re, lam_im, log_dt, b_re, b_im, c_re, c_im, d_skip, glu_w, glu_b):
    bsz, seq, _ = u.shape
    ug = u.reshape(bsz, seq, SSM_GROUPS, SSM_CH)
    dt = jnp.exp(log_dt)[..., None]
    mag = jnp.exp(lam_re * dt)
    lb_re = mag * jnp.cos(lam_im * dt)
    lb_im = mag * jnp.sin(lam_im * dt)
    den = lam_re * lam_re + lam_im * lam_im
    nr = lb_re - 1.0
    coef_re = (nr * lam_re + lb_im * lam_im) / den
    coef_im = (lb_im * lam_re - nr * lam_im) / den
    bb_re = coef_re[..., None] * b_re - coef_im[..., None] * b_im
    bb_im = coef_re[..., None] * b_im + coef_im[..., None] * b_re
    bu_re = _flip_backward(jnp.einsum('bsgh,dgph->dbsgp', ug, bb_re))
    bu_im = _flip_backward(jnp.einsum('bsgh,dgph->dbsgp', ug, bb_im))
    a_re = jnp.broadcast_to(lb_re[:, None, None], bu_re.shape)
    a_im = jnp.broadcast_to(lb_im[:, None, None], bu_re.shape)
    _, _, x_re, x_im = lax.associative_scan(_cplx_affine_combine, (a_re, a_im, bu_re, bu_im), axis=2)
    x_re = _flip_backward(x_re)
    x_im = _flip_backward(x_im)
    y = (jnp.einsum('dbsgp,dghp->bsgh', x_re, c_re)
         - jnp.einsum('dbsgp,dghp->bsgh', x_im, c_im)
         + d_skip * ug)
    y = jax.nn.gelu(y.reshape(bsz, seq, W_SSM))
    return y * jax.nn.sigmoid(y @ glu_w + glu_b)


def _rwkv7_mixer(xn, p_rkv, mu_rkv, mu_w, mu_a, mu_g, w0, w1, w2, a0, a1, a2,
                 g1, g2, k_k, k_a, r_k, gn_g, gn_b):
    bsz, seq, _ = xn.shape
    shifted = jnp.stack([_shift_prev(p_rkv), _shift_next(p_rkv)])
    rkv = p_rkv + (shifted - p_rkv) * mu_rkv[:, None, None, :]
    r, k, v = jnp.split(rkv, 3, axis=-1)
    x_prev = _shift_prev(xn)
    x_next = _shift_next(xn)
    dx = jnp.stack([x_prev, x_next]) - xn
    xw = xn + dx * mu_w[:, None, None, :]
    xa = xn + dx * mu_a[:, None, None, :]
    xg = xn + (0.5 * (x_prev + x_next) - xn) * mu_g
    w_lora = jnp.einsum('dbsr,dre->dbse', jnp.tanh(jnp.einsum('dbsc,dcr->dbsr', xw, w1)), w2)
    decay = jnp.exp(-RWKV_DECAY_SCALE * jax.nn.sigmoid(w0[:, None, None, :] + w_lora))
    a = jax.nn.sigmoid(a0[:, None, None, :]
                       + jnp.einsum('dbsr,dre->dbse', jnp.einsum('dbsc,dcr->dbsr', xa, a1), a2))
    g = jax.nn.sigmoid(xg @ g1) @ g2

    def heads(z):
        return z.reshape(2, bsz, seq, RWKV_HEADS, RWKV_HEAD)

    r, k, v, decay, a = heads(r), heads(k), heads(v), heads(decay), heads(a)
    kk = k * k_k.reshape(RWKV_HEADS, RWKV_HEAD)
    kkf = kk.astype(jnp.float32)
    kk = (kkf * lax.rsqrt(jnp.sum(kkf * kkf, -1, keepdims=True) + 1e-12)).astype(k.dtype)
    k = k * (1.0 + (a - 1.0) * k_a.reshape(RWKV_HEADS, RWKV_HEAD))
    bonus = jnp.sum(jnp.sum(r * k * r_k, -1, keepdims=True) * v, axis=0)

    def to_time(z):
        return jnp.moveaxis(_flip_backward(z), 2, 0)

    xs = (to_time(r), to_time(decay), to_time(k), to_time(v), to_time(-kk), to_time(kk * a))

    def step(state, inp):
        r_t, w_t, k_t, v_t, ka_t, kb_t = inp
        sa = jnp.einsum('dbhvk,dbhk->dbhv', state, ka_t)
        state = (state * w_t[..., None, :] + sa[..., :, None] * kb_t[..., None, :]
                 + v_t[..., :, None] * k_t[..., None, :])
        return state, jnp.einsum('dbhvk,dbhk->dbhv', state, r_t)

    state0 = jnp.zeros((2, bsz, RWKV_HEADS, RWKV_HEAD, RWKV_HEAD), r.dtype)
    _, ys = lax.scan(step, state0, xs)
    y = jnp.sum(_flip_backward(jnp.moveaxis(ys, 0, 2)), axis=0)
    yf = y.astype(jnp.float32)
    mu = jnp.mean(yf, -1, keepdims=True)
    var = jnp.mean(jnp.square(yf - mu), -1, keepdims=True)
    yn = ((yf - mu) * lax.rsqrt(var + RWKV_GN_EPS)).reshape(bsz, seq, W_RWKV)
    yn = (yn * gn_g + gn_b).astype(xn.dtype)
    return (yn + bonus.reshape(bsz, seq, W_RWKV)) * g


def _short_conv_mixer(p_conv, conv_w):
    bgate, cgate, xc = jnp.split(p_conv, 3, axis=-1)
    z = cgate * xc
    zc = conv_w[0] * _shift_prev(z) + conv_w[1] * z + conv_w[2] * _shift_next(z)
    return bgate * zc


def _fourier_mixer(p_fft):
    bsz, seq, _ = p_fft.shape
    z = p_fft.reshape(bsz, seq, FFT_GROUPS, FFT_CH).astype(jnp.float32)
    f = jnp.fft.fft2(z, axes=(1, 3), norm='ortho').real
    return f.reshape(bsz, seq, W_FFT).astype(p_fft.dtype)


def setup_inputs(seed: int = 0) -> dict:
    key = jax.random.key(seed)
    keys = iter(jax.random.split(key, 48))
    L = DEPTH
    G, P, H = SSM_GROUPS, SSM_STATE, SSM_CH

    def nrm(shape, scale):
        return scale * jax.random.normal(next(keys), shape, jnp.float32)

    def unif(shape, lo, hi):
        return jax.random.uniform(next(keys), shape, jnp.float32, lo, hi)

    inp = {}
    inp['x'] = nrm((BATCH, SEQ, D_MODEL), 1.0)
    inp['ln0_g'] = 1.0 + nrm((D_MODEL,), 0.02)
    inp['ln0_b'] = nrm((D_MODEL,), 0.02)
    inp['w_in'] = nrm((L, D_MODEL, D_IN_PROJ), D_MODEL ** -0.5)
    inp['s5_lambda_re'] = -0.5 + nrm((L, 2, G, P), 0.01)
    inp['s5_lambda_im'] = math.pi * jnp.arange(P, dtype=jnp.float32) + nrm((L, 2, G, P), 0.01)
    inp['s5_log_dt'] = unif((L, 2, G), math.log(DT_MIN), math.log(DT_MAX))
    inp['s5_b_re'] = nrm((L, G, P, H), (2 * H) ** -0.5)
    inp['s5_b_im'] = nrm((L, G, P, H), (2 * H) ** -0.5)
    inp['s5_c_re'] = nrm((L, 2, G, H, P), P ** -0.5)
    inp['s5_c_im'] = nrm((L, 2, G, H, P), P ** -0.5)
    inp['s5_d'] = nrm((L, G, H), 1.0)
    inp['s5_glu_w'] = nrm((L, W_SSM, W_SSM), W_SSM ** -0.5)
    inp['s5_glu_b'] = nrm((L, W_SSM), 0.02)
    inp['rwkv_mu_rkv'] = unif((L, 2, 3 * W_RWKV), 0.0, 1.0)
    inp['rwkv_mu_w'] = unif((L, 2, D_MODEL), 0.0, 1.0)
    inp['rwkv_mu_a'] = unif((L, 2, D_MODEL), 0.0, 1.0)
    inp['rwkv_mu_g'] = unif((L, D_MODEL), 0.0, 1.0)
    inp['rwkv_w0'] = nrm((L, 2, W_RWKV), 0.5)
    inp['rwkv_w1'] = nrm((L, 2, D_MODEL, DECAY_LORA), D_MODEL ** -0.5)
    inp['rwkv_w2'] = nrm((L, 2, DECAY_LORA, W_RWKV), DECAY_LORA ** -0.5)
    inp['rwkv_a0'] = nrm((L, 2, W_RWKV), 0.1)
    inp['rwkv_a1'] = nrm((L, 2, D_MODEL, AAA_LORA), D_MODEL ** -0.5)
    inp['rwkv_a2'] = nrm((L, 2, AAA_LORA, W_RWKV), AAA_LORA ** -0.5)
    inp['rwkv_g1'] = nrm((L, D_MODEL, GATE_LORA), D_MODEL ** -0.5)
    inp['rwkv_g2'] = nrm((L, GATE_LORA, W_RWKV), GATE_LORA ** -0.5)
    inp['rwkv_k_k'] = 0.85 + nrm((L, W_RWKV), 0.02)
    inp['rwkv_k_a'] = 1.0 + nrm((L, W_RWKV), 0.02)
    inp['rwkv_r_k'] = nrm((L, RWKV_HEADS, RWKV_HEAD), 0.1)
    inp['rwkv_gn_g'] = 1.0 + nrm((L, W_RWKV), 0.02)
    inp['rwkv_gn_b'] = nrm((L, W_RWKV), 0.02)
    inp['conv_w'] = nrm((L, CONV_WIDTH, W_CONV), CONV_WIDTH ** -0.5)
    inp['w_out'] = nrm((L, D_MIX, D_MODEL), DEEPNORM_BETA * D_MIX ** -0.5)
    inp['ln1_g'] = 1.0 + nrm((L, D_MODEL), 0.02)
    inp['ln1_b'] = nrm((L, D_MODEL), 0.02)
    inp['ffn_w1'] = nrm((L, D_MODEL, D_FF), D_MODEL ** -0.5)
    inp['ffn_w3'] = nrm((L, D_MODEL, D_FF), D_MODEL ** -0.5)
    inp['ffn_w2'] = nrm((L, D_FF, D_MODEL), DEEPNORM_BETA * D_FF ** -0.5)
    inp['ln2_g'] = 1.0 + nrm((L, D_MODEL), 0.02)
    inp['ln2_b'] = nrm((L, D_MODEL), 0.02)
    return inp


def reference(x, ln0_g, ln0_b, w_in,
              s5_lambda_re, s5_lambda_im, s5_log_dt, s5_b_re, s5_b_im, s5_c_re, s5_c_im,
              s5_d, s5_glu_w, s5_glu_b,
              rwkv_mu_rkv, rwkv_mu_w, rwkv_mu_a, rwkv_mu_g, rwkv_w0, rwkv_w1, rwkv_w2,
              rwkv_a0, rwkv_a1, rwkv_a2, rwkv_g1, rwkv_g2, rwkv_k_k, rwkv_k_a, rwkv_r_k,
              rwkv_gn_g, rwkv_gn_b,
              conv_w, w_out, ln1_g, ln1_b, ffn_w1, ffn_w3, ffn_w2, ln2_g, ln2_b):
    h = _layer_norm(x, ln0_g, ln0_b)
    splits = [W_SSM, W_SSM + 3 * W_RWKV, W_SSM + 3 * W_RWKV + 3 * W_CONV]
    for l in range(DEPTH):
        p = h @ w_in[l]
        p_ssm, p_rkv, p_conv, p_fft = jnp.split(p, splits, axis=-1)
        y_a = _s5_mixer(p_ssm, s5_lambda_re[l], s5_lambda_im[l], s5_log_dt[l],
                        s5_b_re[l], s5_b_im[l], s5_c_re[l], s5_c_im[l], s5_d[l],
                        s5_glu_w[l], s5_glu_b[l])
        y_b = _rwkv7_mixer(h, p_rkv, rwkv_mu_rkv[l], rwkv_mu_w[l], rwkv_mu_a[l], rwkv_mu_g[l],
                           rwkv_w0[l], rwkv_w1[l], rwkv_w2[l], rwkv_a0[l], rwkv_a1[l], rwkv_a2[l],
                           rwkv_g1[l], rwkv_g2[l], rwkv_k_k[l], rwkv_k_a[l], rwkv_r_k[l],
                           rwkv_gn_g[l], rwkv_gn_b[l])
        y_c = _short_conv_mixer(p_conv, conv_w[l])
        y_d = _fourier_mixer(p_fft)
        y = jnp.concatenate([y_a, y_b, y_c, y_d], axis=-1)
        h = _layer_norm(DEEPNORM_ALPHA * h + y @ w_out[l], ln1_g[l], ln1_b[l])
        f = (jax.nn.silu(h @ ffn_w1[l]) * (h @ ffn_w3[l])) @ ffn_w2[l]
        h = _layer_norm(DEEPNORM_ALPHA * h + f, ln2_g[l], ln2_b[l])
    return h
```

```cpp
#include <hip/hip_runtime.h>
#include <hip/hip_cooperative_groups.h>
#include <cstdio>
#include <cstdint>
namespace cg = cooperative_groups;
namespace pg8 {
#define PG8_LAS __attribute__((address_space(3)))
typedef unsigned short bf16_t;
typedef short bf16x8 __attribute__((ext_vector_type(8)));
typedef float f32x4 __attribute__((ext_vector_type(4)));
typedef unsigned u32x4 __attribute__((ext_vector_type(4)));
constexpr int BM = 256, BK = 64, HALF = 128, HTB = HALF * BK * 2  , STAGE_BYTES = 8 * HTB, NXCD = 8, WGM = 8;

__host__ __device__ __forceinline__ int lds_byte(int r, int c) { const int st = (r >> 4) * 2 + (c >> 5), rr = r & 15, cc = c & 31, ob = rr * 64 + cc * 2; return st * 1024 + (ob ^ (((ob >> 9) & 1) << 5)); }
__host__ __device__ __forceinline__ void stage_rc(int b, int& R, int& C) { const int st = b / 1024, sb = b % 1024, swz = sb ^ (((sb >> 9) & 1) << 5); R = (st >> 1) * 16 + swz / 64; C = (st & 1) * 32 + (swz % 64) / 2; }
__host__ __device__ __forceinline__ int perm32(int rho) { const int n = rho >> 4, i = rho & 15; return 8 * (i >> 2) + 4 * n + (i & 3); }

struct Unit { int pm, pn; };
struct Gemm { const bf16_t* A; const bf16_t* Bt; int M, N, K; int a_rs, a_k16, a_kstep, a_pn, ksplit; long a_delta; };
__host__ __device__ __forceinline__ Gemm mk_gemm(const bf16_t* A, const bf16_t* Bt, int M, int N, int K) { Gemm g; g.A = A; g.Bt = Bt; g.M = M; g.N = N; g.K = K; g.a_rs = 2 * K; g.a_k16 = 32; g.a_kstep = 128; g.a_pn = 0; g.ksplit = 1 << 30; g.a_delta = 0; return g; }
struct StaticOrder {
    int nM, nN, nwg, G, c;
    __host__ __device__ void init(int M, int N, int G_, int c_) { nM = M / BM; nN = N / BM; nwg = nM * nN; G = G_; c = c_; }
    __host__ __device__ bool next(int i, Unit& u) const {
        const long L = (long)i * G + c; if (L >= nwg) return false;
        int wgid = (int)L; { const int q = nwg / NXCD, r = nwg % NXCD, xcd = wgid % NXCD, off = wgid / NXCD; wgid = (xcd < r ? xcd * (q + 1) : r * (q + 1) + (xcd - r) * q) + off; }
        const int nig = WGM * nN, gid = wgid / nig, fm = gid * WGM, gsz = (nM - fm) < WGM ? (nM - fm) : WGM;
        u.pm = fm + ((wgid % nig) % gsz); u.pn = (wgid % nig) / gsz; return true;
    }
    __device__ __forceinline__ void a_ready(const Unit&) const {}
    __device__ __forceinline__ void done(const Unit&) const {}
};
__device__ __forceinline__ unsigned cvt_pk_bf16(float lo, float hi) { unsigned r; asm volatile("v_cvt_pk_bf16_f32 %0, %1, %2" : "=v"(r) : "v"(lo), "v"(hi)); return r; }
template <class Epi, class Sched, bool ALIGN_EPI = false, bool SP2 = false, bool GEN = false>
__device__ __forceinline__ void gemm_phase(PG8_LAS unsigned char* lds, const Gemm g, const Sched& S, const Epi& E, int wave_id) {
    int lane_l = __builtin_amdgcn_mbcnt_hi(~0u, __builtin_amdgcn_mbcnt_lo(~0u, 0u)); asm volatile("" : "+v"(lane_l)); const int tid_l = wave_id * 64 + lane_l;
    const int tid = tid_l, wid = wave_id, lane = lane_l, wr = wid >> 2, wc = wid & 3, fr = lane & 15, fq = lane >> 4;
    const int K = g.K, nt = K / BK;
    unsigned voffA[2], voffB[2];
#pragma unroll
    for (int i = 0; i < 2; ++i) { int R, C; stage_rc(tid * 16 + i * 8192, R, C); const int Rb = Epi::PERM ? ((R & ~31) + perm32(R & 31)) : R;
        voffA[i] = GEN ? (unsigned)(R * g.a_rs + (C >> 4) * g.a_k16 + (C & 15) * 2) : (unsigned)(R * K + C) * 2u; voffB[i] = (unsigned)(Rb * K + C) * 2u; }
    const size_t kstep = (size_t)(BK * 2);
    const size_t hstep = (size_t)HALF * K * 2;
    const size_t tstep = 2 * hstep;
    const size_t hstepA = GEN ? (size_t)HALF * g.a_rs : hstep, tstepA = 2 * hstepA; const int ksplit = g.ksplit; const long a_delta = g.a_delta; const size_t akstep = GEN ? (size_t)g.a_kstep : kstep;
#define PG8_AP(base, kt) (GEN ? ((base) + (size_t)(kt) * akstep + ((kt) >= ksplit ? a_delta : 0l)) : ((base) + (size_t)(kt) * kstep))
    const unsigned ldsw = (unsigned)wid * 1024u;
    const int aoff = lds_byte(wr * 64 + fr, fq * 8), boff = lds_byte(wc * 32 + fr, fq * 8);
#define PG8_SA(b, h) (((b) * 2 + (h)) * HTB)
#define PG8_SB(b, h) ((4 + (b) * 2 + (h)) * HTB)
#define PG8_STAGE(bufoff, gbase, voff) do { _Pragma("unroll") for (int _i = 0; _i < 2; ++_i) \
        __builtin_amdgcn_global_load_lds((const unsigned*)((const char*)(gbase) + (voff)[_i]), (PG8_LAS unsigned*)(lds + (bufoff) + ldsw + _i * 8192), 16, 0, 0); } while (0)
#define PG8_LDA(dst, b, h) do { _Pragma("unroll") for (int m = 0; m < 4; ++m) _Pragma("unroll") for (int k = 0; k < 2; ++k) dst[m][k] = *(const PG8_LAS bf16x8*)(lds + PG8_SA(b, h) + aoff + m * 2048 + k * 1024); } while (0)
#define PG8_LDB(dst, b, h) do { _Pragma("unroll") for (int n = 0; n < 2; ++n) _Pragma("unroll") for (int k = 0; k < 2; ++k) dst[n][k] = *(const PG8_LAS bf16x8*)(lds + PG8_SB(b, h) + boff + n * 2048 + k * 1024); } while (0)
#define PG8_MMA(ai, bj, At, Bt) do { __builtin_amdgcn_s_setprio(1); _Pragma("unroll") for (int m = 0; m < 4; ++m) _Pragma("unroll") for (int n = 0; n < 2; ++n) _Pragma("unroll") for (int k = 0; k < 2; ++k) \
        acc[ai][bj][m][n] = __builtin_amdgcn_mfma_f32_16x16x32_bf16(Bt[n][k], At[m][k], acc[ai][bj][m][n], 0, 0, 0); __builtin_amdgcn_s_setprio(0); } while (0)
#define PG8_WAIT_V(n) asm volatile("s_waitcnt vmcnt(" #n ")" ::: "memory")
#define PG8_WAIT_L(n) asm volatile("s_waitcnt lgkmcnt(" #n ")" ::: "memory")
#define PG8_BAR __builtin_amdgcn_s_barrier()
#define PG8_SCHED __builtin_amdgcn_sched_barrier(0)
    Unit cur, nxt; int ui = 0;
    if (!S.next(0, cur)) return;
    f32x4 acc[2][2][4][2];
#pragma unroll
    for (int a = 0; a < 2; ++a)
#pragma unroll
        for (int b = 0; b < 2; ++b)
#pragma unroll
            for (int m = 0; m < 4; ++m)
#pragma unroll
                for (int n = 0; n < 2; ++n) acc[a][b][m][n] = (f32x4){0.f, 0.f, 0.f, 0.f};
    bf16x8 At[4][2], B0[2][2], B1[2][2];
    const char* cA = (const char*)g.A + (size_t)cur.pm * tstepA + (GEN ? (size_t)cur.pn * g.a_pn : (size_t)0); const char* cB = (const char*)g.Bt + (size_t)cur.pn * tstep;
    S.a_ready(cur);
    if constexpr (SP2) {
        PG8_STAGE(PG8_SB(0, 0), cB, voffB); PG8_STAGE(PG8_SB(0, 1), cB + hstep, voffB); PG8_STAGE(PG8_SA(0, 0), PG8_AP(cA, 0), voffA); PG8_STAGE(PG8_SA(0, 1), PG8_AP(cA, 0) + hstepA, voffA);
        if (wr == 1) PG8_BAR;
        PG8_WAIT_V(2); PG8_BAR;
        PG8_STAGE(PG8_SB(1, 0), cB + kstep, voffB); PG8_STAGE(PG8_SA(1, 0), PG8_AP(cA, 1), voffA); PG8_STAGE(PG8_SB(1, 1), cB + hstep + kstep, voffB);
        PG8_WAIT_V(6); PG8_BAR;
    } else {
        PG8_STAGE(PG8_SB(0, 0), cB, voffB); PG8_STAGE(PG8_SA(0, 0), PG8_AP(cA, 0), voffA); PG8_STAGE(PG8_SB(0, 1), cB + hstep, voffB); PG8_STAGE(PG8_SA(0, 1), PG8_AP(cA, 0) + hstepA, voffA);
        if (wr == 1) PG8_BAR;
        PG8_WAIT_V(4); PG8_BAR;
        PG8_STAGE(PG8_SB(1, 0), cB + kstep, voffB); PG8_STAGE(PG8_SA(1, 0), PG8_AP(cA, 1), voffA); PG8_STAGE(PG8_SB(1, 1), cB + hstep + kstep, voffB);
        PG8_WAIT_V(6); PG8_BAR;
    }
    for (;;) {
        const bool has_next = S.next(ui + 1, nxt);
        const char* nA = has_next ? (const char*)g.A + (size_t)nxt.pm * tstepA + (GEN ? (size_t)nxt.pn * g.a_pn : (size_t)0) : cA; const char* nB = has_next ? (const char*)g.Bt + (size_t)nxt.pn * tstep : cB;
        for (int t = 0; t < nt; t += 2) {
            const bool last = (t == nt - 2);
            const char* a1 = PG8_AP(cA, t + 1);
            const char* a2 = last ? PG8_AP(nA, 0) : PG8_AP(cA, t + 2); const char* b2 = last ? nB : cB + (size_t)(t + 2) * kstep;
            const char* a3 = last ? PG8_AP(nA, 1) : PG8_AP(cA, t + 3); const char* b3 = b2 + kstep;
            if (last && has_next) S.a_ready(nxt);
            if constexpr (SP2) {
            PG8_LDB(B0, 0, 0); PG8_LDB(B1, 0, 1); PG8_SCHED; PG8_LDA(At, 0, 0); PG8_STAGE(PG8_SA(1, 1), a1 + hstepA, voffA);
            PG8_WAIT_V(8); PG8_WAIT_L(0); PG8_BAR; PG8_MMA(0, 0, At, B0); PG8_MMA(0, 1, At, B1); PG8_BAR; PG8_SCHED;
            PG8_LDA(At, 0, 1); PG8_STAGE(PG8_SB(0, 0), b2, voffB); PG8_STAGE(PG8_SB(0, 1), b2 + hstep, voffB); PG8_STAGE(PG8_SA(0, 0), a2, voffA);
            PG8_WAIT_V(8); PG8_WAIT_L(0); PG8_BAR; PG8_MMA(1, 0, At, B0); PG8_MMA(1, 1, At, B1); PG8_BAR; PG8_SCHED;
            PG8_LDB(B0, 1, 0); PG8_LDB(B1, 1, 1); PG8_SCHED; PG8_LDA(At, 1, 0); PG8_STAGE(PG8_SA(0, 1), a2 + hstepA, voffA);
            PG8_WAIT_V(8); PG8_WAIT_L(0); PG8_BAR; PG8_MMA(0, 0, At, B0); PG8_MMA(0, 1, At, B1); PG8_BAR; PG8_SCHED;
            PG8_LDA(At, 1, 1); PG8_STAGE(PG8_SB(1, 0), b3, voffB); PG8_STAGE(PG8_SB(1, 1), b3 + hstep, voffB); PG8_STAGE(PG8_SA(1, 0), a3, voffA);
            PG8_WAIT_V(8); PG8_WAIT_L(0); PG8_BAR; PG8_MMA(1, 0, At, B0); PG8_MMA(1, 1, At, B1); PG8_BAR; PG8_SCHED;
            } else {
            PG8_LDB(B0, 0, 0); PG8_SCHED; PG8_LDA(At, 0, 0); PG8_STAGE(PG8_SA(1, 1), a1 + hstepA, voffA);
            PG8_WAIT_L(8); PG8_BAR; PG8_WAIT_L(0); PG8_MMA(0, 0, At, B0); PG8_BAR; PG8_SCHED;
            PG8_LDB(B1, 0, 1); PG8_STAGE(PG8_SB(0, 0), b2, voffB);
            PG8_BAR; PG8_WAIT_L(0); PG8_MMA(0, 1, At, B1); PG8_BAR;
            PG8_LDA(At, 0, 1); PG8_STAGE(PG8_SA(0, 0), a2, voffA);
            PG8_BAR; PG8_WAIT_L(0); PG8_MMA(1, 0, At, B0); PG8_BAR; PG8_SCHED;
            PG8_STAGE(PG8_SB(0, 1), b2 + hstep, voffB);
            PG8_WAIT_V(6); PG8_BAR; PG8_MMA(1, 1, At, B1); PG8_BAR;
            PG8_LDB(B0, 1, 0); PG8_SCHED; PG8_LDA(At, 1, 0); PG8_STAGE(PG8_SA(0, 1), a2 + hstepA, voffA);
            PG8_WAIT_L(8); PG8_BAR; PG8_WAIT_L(0); PG8_MMA(0, 0, At, B0); PG8_BAR; PG8_SCHED;
            PG8_LDB(B1, 1, 1); PG8_STAGE(PG8_SB(1, 0), b3, voffB);
            PG8_BAR; PG8_WAIT_L(0); PG8_MMA(0, 1, At, B1); PG8_BAR;
            PG8_LDA(At, 1, 1); PG8_STAGE(PG8_SA(1, 0), a3, voffA);
            PG8_BAR; PG8_WAIT_L(0); PG8_MMA(1, 0, At, B0); PG8_BAR; PG8_SCHED;
            PG8_STAGE(PG8_SB(1, 1), b3 + hstep, voffB);
            PG8_WAIT_V(6); PG8_BAR; PG8_MMA(1, 1, At, B1); PG8_BAR;
            }
        }
        if constexpr (ALIGN_EPI) { if (wr == 0) PG8_BAR; }
        if constexpr (!Epi::AFTER_DRAIN) { E(acc, cur, wr, wc, fr, fq); S.done(cur); }
        if (!has_next) break;
#pragma unroll
        for (int a = 0; a < 2; ++a)
#pragma unroll
            for (int b = 0; b < 2; ++b)
#pragma unroll
                for (int m = 0; m < 4; ++m)
#pragma unroll
                    for (int n = 0; n < 2; ++n) acc[a][b][m][n] = (f32x4){0.f, 0.f, 0.f, 0.f};
        cur = nxt; cA = nA; cB = nB; ++ui;
        if constexpr (ALIGN_EPI) { if (wr == 1) PG8_BAR; }
    }
    PG8_WAIT_V(0);
    if constexpr (!ALIGN_EPI) { if (wr == 0) PG8_BAR; }
    PG8_BAR;
    if constexpr (Epi::AFTER_DRAIN) { E.fused(acc, cur, wr, wc, fr, fq, lds, wid, lane); S.done(cur); }
#undef PG8_AP
#undef PG8_SA
#undef PG8_SB
#undef PG8_STAGE
#undef PG8_LDA
#undef PG8_LDB
#undef PG8_MMA
#undef PG8_WAIT_V
#undef PG8_WAIT_L
#undef PG8_BAR
#undef PG8_SCHED
}
}

#define LAS __attribute__((address_space(3)))
#define GAS __attribute__((address_space(1)))
typedef unsigned short bf16;
typedef float f32x4 __attribute__((ext_vector_type(4)));
typedef float f32x2 __attribute__((ext_vector_type(2)));
typedef unsigned u32x4 __attribute__((ext_vector_type(4)));
typedef unsigned u32x2 __attribute__((ext_vector_type(2)));

constexpr int T = 16384, SEQ = 8192, D = 1024, NL = 2, DFF = 2816, NTHR = 512;
constexpr float LN_EPS = 1e-5f, DN_ALPHA = 1.4142135623730951f, GN_EPS = 64e-5f, DECAY_SCALE = 0.6065306597126334f;
constexpr float FFT_SCALE = 0.0013810679320049757f;
constexpr size_t MiB = (size_t)1 << 20;
constexpr size_t WS_WB = 1 * MiB;
constexpr size_t WB_WIN = 0, WB_WL2 = 6 * MiB, WB_S5E = WB_WL2 + 1280 * 512 * 2, WB_S5Y = WB_S5E + 2 * MiB, WB_GLU = WB_S5Y + 4 * MiB,
                 WB_WOUT = WB_GLU + 131072, WB_W13 = WB_WOUT + 1024 * 1280 * 2, WB_W2 = WB_W13 + (size_t)5632 * 1024 * 2, WB_SC = WB_W2 + (size_t)1024 * 2816 * 2;
constexpr size_t SC_LB = 0, SC_BB = 2 * 16 * 17 * 64 * 8, SC_KT = SC_BB + 2 * 16 * 64 * 16 * 8, SC_END = SC_KT + 16 * 2 * 16 * 256 * 4;
static_assert(WB_SC + SC_END <= 34 * MiB, "weights region");
constexpr size_t WS_HB = 35 * MiB, WS_PRKV = 67 * MiB, WS_PU = 91 * MiB, WS_Y = 99 * MiB, WS_DA = 139 * MiB, WS_PL = 139 * MiB, WS_PCONV = 179 * MiB, WS_PFFT = 203 * MiB,
                 WS_FM = 211 * MiB, WS_X = 243 * MiB, WS_LA = 35 * MiB, WS_E = 51 * MiB, WS_PQP = 35 * MiB, WS_PQQ = 179 * MiB, WS_YA = 211 * MiB, WS_YSC = 35 * MiB, WS_ACT = 67 * MiB,
                 WS_END = 251 * MiB;
constexpr int LDS_BYTES = 147456;

enum { I_X = 0, I_LN0G, I_LN0B, I_WIN, I_LRE, I_LIM, I_LOGDT, I_BRE, I_BIM, I_CRE, I_CIM, I_S5D, I_GLUW, I_GLUB, I_MURKV, I_MUW, I_MUA, I_MUG, I_W0, I_W1, I_W2, I_A0, I_A1, I_A2,
       I_G1, I_G2, I_KK, I_KA, I_RK, I_GNG, I_GNB, I_CONVW, I_WOUT, I_LN1G, I_LN1B, I_FW1, I_FW3, I_FW2, I_LN2G, I_LN2B, N_IN };
struct Args { const float* in[N_IN]; float* out; unsigned char* ws; int ph_lo, ph_hi; };

__device__ __forceinline__ int lnd(int k) { asm volatile("" : "+s"(k)); return k; }
__device__ __forceinline__ unsigned f2bf(float f) { unsigned u = __builtin_bit_cast(unsigned, f); return (u + 0x7fffu + ((u >> 16) & 1u)) >> 16; }
__device__ __forceinline__ unsigned pk2(float lo, float hi) { return f2bf(lo) | (f2bf(hi) << 16); }
__device__ __forceinline__ float bf2f(unsigned short u) { return __builtin_bit_cast(float, (unsigned)u << 16); }
__device__ __forceinline__ float bflo(unsigned w) { return __builtin_bit_cast(float, w << 16); }
__device__ __forceinline__ float bfhi(unsigned w) { return __builtin_bit_cast(float, w & 0xffff0000u); }
__device__ __forceinline__ float sigm(float x) { return 1.0f / (1.0f + __expf(-x)); }
__device__ __forceinline__ float tanh_(float z) { return 1.0f - 2.0f / (1.0f + __expf(2.0f * z)); }
__device__ __forceinline__ float gelu_tanh(float x) { return 0.5f * x * (1.0f + tanh_(0.7978845608028654f * (x + 0.044715f * x * x * x))); }
__device__ __forceinline__ float wave_sum(float v) {
#pragma unroll
    for (int o = 1; o < 64; o <<= 1) v += __shfl_xor(v, o);
    return v;
}
#define LDS_FENCE() do { asm volatile("s_waitcnt lgkmcnt(0)" ::: "memory"); __builtin_amdgcn_wave_barrier(); } while (0)
__device__ __forceinline__ f32x2 cmul(f32x2 a, f32x2 b) { return (f32x2){a.x * b.x - a.y * b.y, a.x * b.y + a.y * b.x}; }

using pg8::Unit;
#define EPI_ARGS const f32x4 (&acc)[2][2][4][2], const Unit& u, int wr, int wc, int fr, int fq
__device__ __forceinline__ u32x4 pack8(f32x4 a, f32x4 b) { u32x4 w; w.x = pk2(a[0], a[1]); w.y = pk2(a[2], a[3]); w.z = pk2(b[0], b[1]); w.w = pk2(b[2], b[3]); return w; }

struct EpiP {
    static constexpr bool PERM = true, AFTER_DRAIN = false; bf16 *Pu, *Prkv, *Pconv, *Pfft, *PL;
    __device__ __forceinline__ void operator()(EPI_ARGS) const {
        const int pn = u.pn; bf16* base; int ldc, cofs;
        if (pn == 0) { base = Pu; ldc = 256; cofs = 0; } else if (pn < 4) { base = Prkv; ldc = 768; cofs = (pn - 1) * 256; } else if (pn < 7) { base = Pconv; ldc = 768; cofs = (pn - 4) * 256; }
        else if (pn == 7) { base = Pfft; ldc = 256; cofs = 0; } else { base = PL; ldc = 1024; cofs = (pn - 8) * 256; }
#pragma unroll
        for (int ai = 0; ai < 2; ++ai)
#pragma unroll
            for (int m = 0; m < 4; ++m) { const int row = u.pm * 256 + ai * 128 + wr * 64 + m * 16 + fr;
#pragma unroll
                for (int bj = 0; bj < 2; ++bj) *(u32x4*)(base + (size_t)row * ldc + cofs + bj * 128 + wc * 32 + 8 * fq) = pack8(acc[ai][bj][m][0], acc[ai][bj][m][1]); }
    }
};
struct EpiL2 {
    static constexpr bool PERM = true, AFTER_DRAIN = false; bf16* DA; const float* w0; const float* a0;
    __device__ __forceinline__ void operator()(EPI_ARGS) const {
        const int pn = u.pn;
#pragma unroll
        for (int bj = 0; bj < 2; ++bj) { const int col = pn * 256 + bj * 128 + wc * 32 + 8 * fq; f32x4 b0 = {0.f, 0.f, 0.f, 0.f}, b1 = b0;
            if (pn < 2) { b0 = *(const f32x4*)(w0 + col); b1 = *(const f32x4*)(w0 + col + 4); } else if (pn < 4) { b0 = *(const f32x4*)(a0 + col - 512); b1 = *(const f32x4*)(a0 + col - 508); }
#pragma unroll
            for (int ai = 0; ai < 2; ++ai)
#pragma unroll
                for (int m = 0; m < 4; ++m) { const int row = u.pm * 256 + ai * 128 + wr * 64 + m * 16 + fr; f32x4 v0 = acc[ai][bj][m][0] + b0, v1 = acc[ai][bj][m][1] + b1;
                    if (pn < 2) {
#pragma unroll
                        for (int e = 0; e < 4; ++e) { v0[e] = __expf(-DECAY_SCALE * sigm(v0[e])); v1[e] = __expf(-DECAY_SCALE * sigm(v1[e])); } }
                    else if (pn < 4) {
#pragma unroll
                        for (int e = 0; e < 4; ++e) { v0[e] = sigm(v0[e]); v1[e] = sigm(v1[e]); } }
                    *(u32x4*)(DA + (size_t)row * 1280 + col) = pack8(v0, v1); } }
    }
};
struct EpiE {
    static constexpr bool PERM = false, AFTER_DRAIN = false; float* E;
    __device__ __forceinline__ void operator()(EPI_ARGS) const {
#pragma unroll
        for (int ai = 0; ai < 2; ++ai)
#pragma unroll
            for (int m = 0; m < 4; ++m) { const int row = u.pm * 256 + ai * 128 + wr * 64 + m * 16 + fr;
#pragma unroll
                for (int bj = 0; bj < 2; ++bj)
#pragma unroll
                    for (int n = 0; n < 2; ++n) *(f32x4*)(E + ((size_t)row * 16 + u.pn) * 256 + bj * 128 + wc * 32 + 16 * n + 4 * fq) = acc[ai][bj][m][n]; }
    }
};
struct EpiS5Y {
    static constexpr bool PERM = true, AFTER_DRAIN = false; bf16* YA;
    __device__ __forceinline__ void operator()(EPI_ARGS) const {
#pragma unroll
        for (int ai = 0; ai < 2; ++ai)
#pragma unroll
            for (int m = 0; m < 4; ++m) { const int row = u.pm * 256 + ai * 128 + wr * 64 + m * 16 + fr;
#pragma unroll
                for (int bj = 0; bj < 2; ++bj) { const int n0 = bj * 128 + wc * 32 + 8 * fq; f32x4 v0 = acc[ai][bj][m][0], v1 = acc[ai][bj][m][1];
#pragma unroll
                    for (int e = 0; e < 4; ++e) { v0[e] = gelu_tanh(v0[e]); v1[e] = gelu_tanh(v1[e]); }
                    *(u32x4*)(YA + ((size_t)row * 16 + (n0 >> 4)) * 256 + u.pn * 16 + (n0 & 15)) = pack8(v0, v1); } }
    }
};
struct EpiGLU {
    static constexpr bool PERM = true, AFTER_DRAIN = false; const bf16* YA; bf16* Y; const float* gb;
    __device__ __forceinline__ void operator()(EPI_ARGS) const {
#pragma unroll
        for (int bj = 0; bj < 2; ++bj) { const int col = bj * 128 + wc * 32 + 8 * fq; const f32x4 b0 = *(const f32x4*)(gb + col), b1 = *(const f32x4*)(gb + col + 4);
#pragma unroll
            for (int ai = 0; ai < 2; ++ai)
#pragma unroll
                for (int m = 0; m < 4; ++m) { const int row = u.pm * 256 + ai * 128 + wr * 64 + m * 16 + fr; const u32x4 yw = *(const u32x4*)(YA + (size_t)row * 256 + col);
                    f32x4 v0 = acc[ai][bj][m][0] + b0, v1 = acc[ai][bj][m][1] + b1;
                    v0[0] = bflo(yw.x) * sigm(v0[0]); v0[1] = bfhi(yw.x) * sigm(v0[1]); v0[2] = bflo(yw.y) * sigm(v0[2]); v0[3] = bfhi(yw.y) * sigm(v0[3]);
                    v1[0] = bflo(yw.z) * sigm(v1[0]); v1[1] = bfhi(yw.z) * sigm(v1[1]); v1[2] = bflo(yw.w) * sigm(v1[2]); v1[3] = bfhi(yw.w) * sigm(v1[3]);
                    *(u32x4*)(Y + (size_t)row * 1280 + col) = pack8(v0, v1); } }
    }
};
struct EpiRes {
    static constexpr bool PERM = false, AFTER_DRAIN = false; float* Hf;
    __device__ __forceinline__ void operator()(EPI_ARGS) const {
#pragma unroll
        for (int ai = 0; ai < 2; ++ai)
#pragma unroll
            for (int m = 0; m < 4; ++m) { const int row = u.pm * 256 + ai * 128 + wr * 64 + m * 16 + fr;
#pragma unroll
                for (int bj = 0; bj < 2; ++bj)
#pragma unroll
                    for (int n = 0; n < 2; ++n) { float* p = Hf + (size_t)row * D + u.pn * 256 + bj * 128 + wc * 32 + 16 * n + 4 * fq; const f32x4 v = *(const f32x4*)p; *(f32x4*)p = v * DN_ALPHA + acc[ai][bj][m][n]; } }
    }
};
struct EpiSwi {
    static constexpr bool PERM = true, AFTER_DRAIN = false; bf16* ACT;
    __device__ __forceinline__ void operator()(EPI_ARGS) const {
#pragma unroll
        for (int ai = 0; ai < 2; ++ai)
#pragma unroll
            for (int m = 0; m < 4; ++m) { const int row = u.pm * 256 + ai * 128 + wr * 64 + m * 16 + fr; f32x4 v0 = acc[ai][0][m][0], v1 = acc[ai][0][m][1]; const f32x4 g0 = acc[ai][1][m][0], g1 = acc[ai][1][m][1];
#pragma unroll
                for (int e = 0; e < 4; ++e) { v0[e] = v0[e] * sigm(v0[e]) * g0[e]; v1[e] = v1[e] * sigm(v1[e]) * g1[e]; }
                *(u32x4*)(ACT + (size_t)row * DFF + u.pn * 128 + wc * 32 + 8 * fq) = pack8(v0, v1); }
    }
};

__device__ __forceinline__ void tr_item(const float* __restrict__ W, int ldw, int Ksrc, int Nsrc, int k0, int n0, const float* __restrict__ mu, float sa, float sb,
                                        bf16* WT, int ldk, long drow0, int dk0, LAS float* scr, int lane) {
    const int nn = n0 + (lane & 31);
#pragma unroll 4
    for (int i = 0; i < 32; ++i) { const int kk = 2 * i + (lane >> 5), k = k0 + kk; float v = 0.f;
        if (k < Ksrc && nn < Nsrc) { v = W[(size_t)k * ldw + nn]; if (mu) v *= (sa + sb * mu[k]); }
        scr[kk * 33 + (lane & 31)] = v; }
    LDS_FENCE();
    const int c = lane & 7;
#pragma unroll
    for (int j = 0; j < 4; ++j) { const int n = (lane >> 3) + 8 * j; const LAS float* s = scr + (8 * c) * 33 + n;
        u32x4 o; o.x = pk2(s[0 * 33], s[1 * 33]); o.y = pk2(s[2 * 33], s[3 * 33]); o.z = pk2(s[4 * 33], s[5 * 33]); o.w = pk2(s[6 * 33], s[7 * 33]);
        *(u32x4*)(WT + (size_t)(drow0 + n) * ldk + dk0 + 8 * c) = o; }
    LDS_FENCE();
}

__device__ __forceinline__ void prep_weights(const Args& A, GAS unsigned char* ws_, int l, LAS unsigned char* lds, int wave, int lane, int gw, int NGW) {
    GAS unsigned char* wb = ws_ + WS_WB;
    bf16* WIN = (bf16*)(wb + WB_WIN); bf16* WL2 = (bf16*)(wb + WB_WL2); bf16* GLU = (bf16*)(wb + WB_GLU); bf16* WOUT = (bf16*)(wb + WB_WOUT); bf16* W13 = (bf16*)(wb + WB_W13); bf16* W2 = (bf16*)(wb + WB_W2);
    f32x2* LB = (f32x2*)(wb + WB_SC + SC_LB); f32x2* BB = (f32x2*)(wb + WB_SC + SC_BB);
    LAS float* scr = (LAS float*)(lds + wave * 16384);
    LAS float* trig = scr + 2112;
    { float sn, cs; sincospif((float)lane * (1.0f / 32.0f), &sn, &cs); trig[lane] = cs; trig[64 + lane] = sn; }
    LDS_FENCE();
    constexpr int J1 = 16 * 64, J2 = 128, J3 = 128, J4 = 160, J5 = 96, J6 = 320, J7 = 32, J8 = 12 * 32, J9 = 1024, J10 = 2 * 16 * 88, J11 = 44 * 32, J12 = 32;
    constexpr int NIT = J1 + J2 + J3 + J4 + J5 + J6 + J7 + J8 + J9 + J10 + J11 + J12;
    for (int it = gw; it < NIT; it += NGW) {
        int r = it;
        const float* src = nullptr; const float* mu = nullptr; int ldw = 0, Ks = 0, Ns = 0, k0 = 0, n0 = 0, ldk = 1024, dk0 = 0; long drow0 = 0; float sa = 1.f, sb = 0.f; bf16* WT = WIN; int kind = 0;
        if (r < J1) { src = A.in[lnd(I_WIN)] + (size_t)l * 1024 * 2048; ldw = 2048; Ks = 1024; Ns = 2048; k0 = (r >> 6) * 64; n0 = (r & 63) * 32; drow0 = n0; dk0 = k0; }
        else if ((r -= J1) < J2 + J3) { const int isa = r >= J2; if (isa) r -= J2; const int nb = r & 1, kb = (r >> 1) & 15, part = (r >> 5) & 1, d = r >> 6;
            src = A.in[lnd(isa ? I_A1 : I_W1)] + ((size_t)l * 2 + d) * 1024 * 64; mu = A.in[lnd(isa ? I_MUA : I_MUW)] + ((size_t)l * 2 + d) * 1024;
            ldw = 64; Ks = 1024; Ns = 64; k0 = kb * 64; n0 = nb * 32; sa = part ? 0.f : 1.f; sb = part ? 1.f : -1.f; drow0 = 2048 + isa * 256 + d * 128 + part * 64 + nb * 32; dk0 = k0; }
        else if ((r -= J2 + J3) < J4) { const int part = r / 80, q = r % 80, kb = q / 5, nb = q % 5;
            src = A.in[lnd(I_G1)] + (size_t)l * 1024 * 160; mu = A.in[lnd(I_MUG)] + (size_t)l * 1024; ldw = 160; Ks = 1024; Ns = 160; k0 = kb * 64; n0 = nb * 32; sa = part ? 0.f : 1.f; sb = part ? 0.5f : -1.f; drow0 = 2560 + part * 160 + nb * 32; dk0 = k0; }
        else if ((r -= J4) < J5) { drow0 = 2880 + (r / 16) * 32; dk0 = (r % 16) * 64; }
        else if ((r -= J5) < J6) { const int rb = r >> 3, kb = r & 7, row0 = rb * 32; WT = WL2; ldk = 512; drow0 = row0; dk0 = kb * 64; ldw = 256; Ns = 256;
            if (row0 < 512) { const int d = row0 >> 8; if (kb == d) { src = A.in[lnd(I_W2)] + ((size_t)l * 2 + d) * 64 * 256; Ks = 64; n0 = row0 & 255; } }
            else if (row0 < 1024) { const int d = (row0 - 512) >> 8; if (kb == 2 + d) { src = A.in[lnd(I_A2)] + ((size_t)l * 2 + d) * 64 * 256; Ks = 64; n0 = row0 & 255; } }
            else if (kb >= 4 && kb < 7) { src = A.in[lnd(I_G2)] + (size_t)l * 160 * 256; Ks = 160; k0 = (kb - 4) * 64; n0 = row0 - 1024; } }
        else if ((r -= J6) < J7) { src = A.in[lnd(I_GLUW)] + (size_t)l * 65536; ldw = 256; Ks = 256; Ns = 256; k0 = (r >> 3) * 64; n0 = (r & 7) * 32; WT = GLU; ldk = 256; drow0 = n0; dk0 = k0; }
        else if ((r -= J7) < J8) { src = A.in[lnd(I_WOUT)] + (size_t)l * 1024 * 1024; ldw = 1024; Ks = 768; Ns = 1024; k0 = (r >> 5) * 64; n0 = (r & 31) * 32; WT = WOUT; ldk = 1280; drow0 = n0; dk0 = k0; }
        else if ((r -= J8) < J9) kind = 1;
        else if ((r -= J9) < J10) { const int w3 = r >= 1408; if (w3) r -= 1408; const int kb = r / 88, nb = r % 88; n0 = nb * 32; k0 = kb * 64;
            src = A.in[lnd(w3 ? I_FW3 : I_FW1)] + (size_t)l * 1024 * DFF; ldw = DFF; Ks = 1024; Ns = DFF; WT = W13; ldk = 1024; drow0 = (n0 >> 7) * 256 + w3 * 128 + (n0 & 127); dk0 = k0; }
        else if ((r -= J10) < J11) { src = A.in[lnd(I_FW2)] + (size_t)l * DFF * 1024; ldw = 1024; Ks = DFF; Ns = 1024; k0 = (r >> 5) * 64; n0 = (r & 31) * 32; WT = W2; ldk = DFF; drow0 = n0; dk0 = k0; }
        else { r -= J11; kind = 2; }
        if (kind == 0) { tr_item(src, ldw, Ks, Ns, k0, n0, mu, sa, sb, WT, ldk, drow0, dk0, scr, lane); continue; }
        if (kind == 1) { const int c8 = r & 7, nb = (r >> 3) & 31, g = r >> 8; const float* W = A.in[lnd(I_WOUT)] + (size_t)l * 1024 * 1024 + (size_t)(768 + g * 64) * 1024 + nb * 32;
#pragma unroll 4
            for (int i = 0; i < 32; ++i) { const int kk = 2 * i + (lane >> 5); scr[kk * 33 + (lane & 31)] = W[(size_t)kk * 1024 + (lane & 31)]; }
            LDS_FENCE();
            const int n = lane & 31, part = lane >> 5; float o[8];
#pragma unroll
            for (int q = 0; q < 8; ++q) { const int c = c8 * 8 + q; float s = 0.f;
#pragma unroll 4
                for (int cp = 0; cp < 64; ++cp) s += trig[part * 64 + ((c * cp) & 63)] * scr[cp * 33 + n];
                o[q] = s; }
            u32x4 w; w.x = pk2(o[0], o[1]); w.y = pk2(o[2], o[3]); w.z = pk2(o[4], o[5]); w.w = pk2(o[6], o[7]);
            *(u32x4*)(WOUT + (size_t)(nb * 32 + n) * 1280 + 768 + g * 128 + part * 64 + c8 * 8) = w;
            LDS_FENCE(); continue; }
        {
            const int d = r >> 4, g = r & 15, p = lane; const size_t dg = (size_t)(l * 2 + d) * 16 + g;
            const float lre = A.in[lnd(I_LRE)][dg * 64 + p], lim = A.in[lnd(I_LIM)][dg * 64 + p], dt = expf(A.in[lnd(I_LOGDT)][dg]);
            const float mag = expf(lre * dt); float sn, cs; sincospif(lim * dt * 0.3183098861837907f, &sn, &cs);
            const f32x2 lb = {mag * cs, mag * sn}; const float den = lre * lre + lim * lim, nr = lb.x - 1.0f;
            const f32x2 coef = {(nr * lre + lb.y * lim) / den, (lb.y * lre - nr * lim) / den};
            f32x2 pw = {1.f, 0.f};
            for (int k = 0; k < 17; ++k) { LB[((size_t)(d * 16 + g) * 17 + k) * 64 + p] = pw; pw = cmul(pw, lb); }
            const float* bre = A.in[lnd(I_BRE)] + (((size_t)l * 16 + g) * 64 + p) * 16; const float* bim = A.in[lnd(I_BIM)] + (((size_t)l * 16 + g) * 64 + p) * 16;
            for (int h = 0; h < 16; ++h) BB[((size_t)(d * 16 + g) * 64 + p) * 16 + h] = cmul(coef, (f32x2){bre[h], bim[h]});
        }
    }
}
__device__ __forceinline__ void prep_s5_b(const Args& A, GAS unsigned char* ws_, int l, int lane, int gw, int NGW) {
    GAS unsigned char* wb = ws_ + WS_WB; bf16* S5E = (bf16*)(wb + WB_S5E);
    const f32x2* LB = (const f32x2*)(wb + WB_SC + SC_LB); const f32x2* BB = (const f32x2*)(wb + WB_SC + SC_BB); float* KT = (float*)(wb + WB_SC + SC_KT);
    for (int it = gw; it < 4096 + 512; it += NGW) {
        if (it < 4096) { const int g = it >> 8, n = it & 255, d = n >> 7, ri = (n >> 6) & 1, p = n & 63, tp = lane >> 2, h0 = (lane & 3) * 4, ex = d ? tp : 15 - tp;
            const f32x2 lbp = LB[((size_t)(d * 16 + g) * 17 + ex) * 64 + p]; float o[4];
#pragma unroll
            for (int e = 0; e < 4; ++e) { const f32x2 pr = cmul(lbp, BB[((size_t)(d * 16 + g) * 64 + p) * 16 + h0 + e]); o[e] = ri ? pr.y : pr.x; }
            u32x2 w; w.x = pk2(o[0], o[1]); w.y = pk2(o[2], o[3]); *(u32x2*)(S5E + ((size_t)g * 256 + n) * 256 + lane * 4) = w;
        } else { const int r = it - 4096, lag = r & 15, d = (r >> 4) & 1, g = r >> 5, h = lane >> 2, h0 = (lane & 3) * 4;
            const float* cre = A.in[lnd(I_CRE)] + ((((size_t)l * 2 + d) * 16 + g) * 16 + h) * 64; const float* cim = A.in[lnd(I_CIM)] + ((((size_t)l * 2 + d) * 16 + g) * 16 + h) * 64;
            float a0 = 0.f, a1 = 0.f, a2 = 0.f, a3 = 0.f;
            for (int p = 0; p < 64; ++p) { const f32x2 w = cmul((f32x2){cre[p], cim[p]}, LB[((size_t)(d * 16 + g) * 17 + lag) * 64 + p]); const f32x2* bb = BB + ((size_t)(d * 16 + g) * 64 + p) * 16 + h0;
                a0 += w.x * bb[0].x - w.y * bb[0].y; a1 += w.x * bb[1].x - w.y * bb[1].y; a2 += w.x * bb[2].x - w.y * bb[2].y; a3 += w.x * bb[3].x - w.y * bb[3].y; }
            *(f32x4*)(KT + ((((size_t)g * 2 + d) * 16 + lag) * 16 + h) * 16 + h0) = (f32x4){a0, a1, a2, a3}; }
    }
}
__device__ __forceinline__ void prep_s5_c(const Args& A, GAS unsigned char* ws_, int l, int lane, int gw, int NGW) {
    GAS unsigned char* wb = ws_ + WS_WB; bf16* S5Y = (bf16*)(wb + WB_S5Y);
    const f32x2* LB = (const f32x2*)(wb + WB_SC + SC_LB); const float* KT = (const float*)(wb + WB_SC + SC_KT);
    for (int it = gw; it < 4096; it += NGW) { const int g = it >> 8, n = it & 255, t = n >> 4, h = n & 15; float o[8];
        if (lane < 32) { const int tp = lane >> 1, h0 = (lane & 1) * 8;
#pragma unroll
            for (int q = 0; q < 8; ++q) { float v = 0.f;
                if (tp <= t) v += KT[((((size_t)g * 2 + 0) * 16 + (t - tp)) * 16 + h) * 16 + h0 + q];
                if (tp >= t) v += KT[((((size_t)g * 2 + 1) * 16 + (tp - t)) * 16 + h) * 16 + h0 + q];
                if (tp == t && h0 + q == h) v += A.in[lnd(I_S5D)][((size_t)l * 16 + g) * 16 + h];
                o[q] = v; }
        } else { const int kk0 = (lane - 32) * 8, d = kk0 >> 7, ri = (kk0 >> 6) & 1, p0 = kk0 & 63, ex = d ? 16 - t : t + 1;
            const float* cre = A.in[lnd(I_CRE)] + ((((size_t)l * 2 + d) * 16 + g) * 16 + h) * 64 + p0; const float* cim = A.in[lnd(I_CIM)] + ((((size_t)l * 2 + d) * 16 + g) * 16 + h) * 64 + p0;
#pragma unroll
            for (int q = 0; q < 8; ++q) { const f32x2 w = cmul((f32x2){cre[q], cim[q]}, LB[((size_t)(d * 16 + g) * 17 + ex) * 64 + p0 + q]); o[q] = ri ? -w.y : w.x; } }
        u32x4 w; w.x = pk2(o[0], o[1]); w.y = pk2(o[2], o[3]); w.z = pk2(o[4], o[5]); w.w = pk2(o[6], o[7]);
        *(u32x4*)(S5Y + ((size_t)g * 256 + n) * 512 + lane * 8) = w; }
}

__device__ __forceinline__ void ln_row(const float* src, const float* gam, const float* bet, float* dstf, bf16* dstb, int lane) {
    const f32x4* xr = (const f32x4*)src + lane; f32x4 v[4]; float s = 0.f;
#pragma unroll
    for (int j = 0; j < 4; ++j) { v[j] = xr[64 * j]; s += (v[j].x + v[j].y) + (v[j].z + v[j].w); }
    const float mean = wave_sum(s) * (1.f / D); float s2 = 0.f;
#pragma unroll
    for (int j = 0; j < 4; ++j) { v[j] = v[j] - mean; s2 += (v[j].x * v[j].x + v[j].y * v[j].y) + (v[j].z * v[j].z + v[j].w * v[j].w); }
    const float rstd = 1.f / sqrtf(wave_sum(s2) * (1.f / D) + LN_EPS);
#pragma unroll
    for (int j = 0; j < 4; ++j) { const f32x4 g4 = ((const f32x4*)gam)[lane + 64 * j], b4 = ((const f32x4*)bet)[lane + 64 * j]; const f32x4 o = v[j] * rstd * g4 + b4;
        ((f32x4*)dstf)[lane + 64 * j] = o; u32x2 w; w.x = pk2(o.x, o.y); w.y = pk2(o.z, o.w); ((u32x2*)dstb)[lane + 64 * j] = w; }
}
__device__ __forceinline__ void ld8(const bf16* p, float (&o)[8]) { const u32x4 w = *(const u32x4*)p; o[0] = bflo(w.x); o[1] = bfhi(w.x); o[2] = bflo(w.y); o[3] = bfhi(w.y); o[4] = bflo(w.z); o[5] = bfhi(w.z); o[6] = bflo(w.w); o[7] = bfhi(w.w); }
__device__ __forceinline__ void lora_act_row(const bf16* PL, bf16* LA, int m, int lane) {
    const int s = m & (SEQ - 1); const bool hp = s > 0, hn = s < SEQ - 1; float o[8];
#pragma unroll
    for (int q = 0; q < 8; ++q) o[q] = 0.f;
    const bf16* row = PL + (size_t)m * 1024;
    if (lane < 32) { const int blk = lane >> 3, c = (lane & 7) * 8, d = blk & 1; float a[8], b[8];
        ld8(row + (blk >> 1) * 256 + d * 128 + c, a);
        const bool ok = d ? hn : hp;
        if (ok) { ld8(row + (d ? 1024 : -1024) + (blk >> 1) * 256 + d * 128 + 64 + c, b);
#pragma unroll
            for (int q = 0; q < 8; ++q) a[q] += b[q]; }
#pragma unroll
        for (int q = 0; q < 8; ++q) o[q] = (blk < 2) ? tanh_(a[q]) : a[q];
    } else if (lane < 52) { const int r = (lane - 32) * 8; float a[8], b[8]; ld8(row + 512 + r, a);
        if (hp) { ld8(row - 1024 + 672 + r, b);
#pragma unroll
            for (int q = 0; q < 8; ++q) a[q] += b[q]; }
        if (hn) { ld8(row + 1024 + 672 + r, b);
#pragma unroll
            for (int q = 0; q < 8; ++q) a[q] += b[q]; }
#pragma unroll
        for (int q = 0; q < 8; ++q) o[q] = sigm(a[q]); }
    u32x4 w; w.x = pk2(o[0], o[1]); w.y = pk2(o[2], o[3]); w.z = pk2(o[4], o[5]); w.w = pk2(o[6], o[7]);
    *(u32x4*)(LA + (size_t)m * 512 + lane * 8) = w;
}
__device__ __forceinline__ void ld4(const bf16* p, float (&o)[4]) { const u32x2 w = *(const u32x2*)p; o[0] = bflo(w.x); o[1] = bfhi(w.x); o[2] = bflo(w.y); o[3] = bfhi(w.y); }
__device__ __forceinline__ void conv_row(const bf16* PC, const float* cw, bf16* Y, int m, int lane) {
    const int s = m & (SEQ - 1), c = lane * 4; const bf16* row = PC + (size_t)m * 768 + c; float bg[4], cg[4], xc[4], z[4], acc[4];
    ld4(row, bg); ld4(row + 256, cg); ld4(row + 512, xc);
    const f32x4 w0 = *(const f32x4*)(cw + c), w1 = *(const f32x4*)(cw + 256 + c), w2 = *(const f32x4*)(cw + 512 + c);
#pragma unroll
    for (int q = 0; q < 4; ++q) acc[q] = w1[q] * (cg[q] * xc[q]);
    if (s > 0) { ld4(row - 768 + 256, cg); ld4(row - 768 + 512, xc);
#pragma unroll
        for (int q = 0; q < 4; ++q) acc[q] += w0[q] * (cg[q] * xc[q]); }
    if (s < SEQ - 1) { ld4(row + 768 + 256, cg); ld4(row + 768 + 512, xc);
#pragma unroll
        for (int q = 0; q < 4; ++q) acc[q] += w2[q] * (cg[q] * xc[q]); }
    (void)z; u32x2 w; w.x = pk2(bg[0] * acc[0], bg[1] * acc[1]); w.y = pk2(bg[2] * acc[2], bg[3] * acc[3]);
    *(u32x2*)(Y + (size_t)m * 1280 + 512 + c) = w;
}

template <int N, int NC>
__device__ __forceinline__ LAS f32x2* fft_lds(LAS f32x2* Abuf, LAS f32x2* Bbuf, const LAS f32x2* tw, int tid) {
    LAS f32x2* X = Abuf; LAS f32x2* Yb = Bbuf;
    for (int p = 1; p < N; p <<= 1) {
        for (int idx = tid; idx < (N / 2) * NC; idx += NTHR) { const int col = idx % NC, i = idx / NC, k = i & (p - 1), j = ((i - k) << 1) + k;
            const f32x2 w = tw[k * (N / 2 / p)], u0 = X[i * NC + col], u1 = cmul(X[(i + N / 2) * NC + col], w);
            Yb[j * NC + col] = u0 + u1; Yb[(j + p) * NC + col] = u0 - u1; }
        __syncthreads();
        LAS f32x2* t = X; X = Yb; Yb = t;
    }
    return X;
}
__device__ __forceinline__ void fft_step1(const bf16* PF, f32x2* FM, LAS unsigned char* lds, int tid, int bid, int G) {
    LAS f32x2* Ab = (LAS f32x2*)lds; LAS f32x2* Bb = (LAS f32x2*)(lds + 65536); LAS f32x2* tw = (LAS f32x2*)(lds + 131072);
    if (tid < 64) { float sn, cs; sincospif((float)tid * (1.0f / 64.0f), &sn, &cs); tw[tid] = (f32x2){cs, -sn}; }
    __syncthreads();
    for (int un = bid; un < 512; un += G) { const int cgp = un & 3, s2 = (un >> 2) & 63, b = un >> 8;
        for (int idx = tid; idx < 1024; idx += NTHR) { const int s1 = idx >> 3, c8 = (idx & 7) * 8; float v[8]; ld8(PF + (size_t)(b * SEQ + 64 * s1 + s2) * 256 + cgp * 64 + c8, v);
#pragma unroll
            for (int q = 0; q < 8; ++q) Ab[s1 * 64 + c8 + q] = (f32x2){v[q], 0.f}; }
        __syncthreads();
        LAS f32x2* R = fft_lds<128, 64>(Ab, Bb, tw, tid);
        for (int idx = tid; idx < 128 * 64; idx += NTHR) { const int k1 = idx >> 6, col = idx & 63; FM[((size_t)(b * 128 + k1) * 64 + s2) * 256 + cgp * 64 + col] = R[idx]; }
        __syncthreads();
    }
}
__device__ __forceinline__ void fft_step3(const f32x2* FM, bf16* Y, LAS unsigned char* lds, int tid, int bid, int G) {
    LAS f32x2* Ab = (LAS f32x2*)lds; LAS f32x2* Bb = (LAS f32x2*)(lds + 65536); LAS f32x2* tw = (LAS f32x2*)(lds + 131072); LAS f32x2* tw2 = tw + 32;
    if (tid < 32) { float sn, cs; sincospif((float)tid * (1.0f / 32.0f), &sn, &cs); tw[tid] = (f32x2){cs, -sn}; }
    __syncthreads();
    for (int un = bid; un < 512; un += G) { const int half = un & 1, k1 = (un >> 1) & 127, b = un >> 8;
        if (tid < 64) { float sn, cs; sincospif((float)((k1 * tid) & 8191) * (1.0f / 4096.0f), &sn, &cs); tw2[tid] = (f32x2){cs, -sn}; }
        __syncthreads();
        for (int idx = tid; idx < 64 * 128; idx += NTHR) { const int s2 = idx >> 7, col = idx & 127; Ab[idx] = cmul(FM[((size_t)(b * 128 + k1) * 64 + s2) * 256 + half * 128 + col], tw2[s2]); }
        __syncthreads();
        LAS f32x2* R = fft_lds<64, 128>(Ab, Bb, tw, tid);
        for (int idx = tid; idx < 64 * 128; idx += NTHR) { const int k2 = idx >> 7, col = idx & 127, cg2 = half * 128 + col, grp = cg2 >> 6, c = cg2 & 63; const f32x2 v = R[idx];
            bf16* yp = Y + (size_t)(b * SEQ + k1 + 128 * k2) * 1280 + 768 + grp * 128 + c; yp[0] = (bf16)f2bf(v.x * FFT_SCALE); yp[64] = (bf16)f2bf(v.y * FFT_SCALE); }
        __syncthreads();
    }
}

__device__ __forceinline__ void s5_carry(const float* E, bf16* X2, const f32x2* LB, LAS unsigned char* lds, int j, int tid) {
    const int b = j >> 5, g = (j >> 1) & 15, d = j & 1, seg = tid >> 6, p = tid & 63;
    LAS f32x2* es = (LAS f32x2*)lds;
    const f32x2 A16 = LB[((size_t)(d * 16 + g) * 17 + 16) * 64 + p];
    const int c0 = d ? seg * 64 + 63 : seg * 64, cs = d ? -1 : 1;
    const float* Eb = E + ((size_t)(b * 512) * 16 + g) * 256 + d * 128 + p;
    f32x2 x = {0.f, 0.f};
#pragma unroll 8
    for (int i = 0; i < 64; ++i) { const int c = c0 + cs * i; const float* e = Eb + (size_t)c * 4096; x = cmul(A16, x) + (f32x2){e[0], e[64]}; }
    es[seg * 64 + p] = x;
    f32x2 A64 = A16;
#pragma unroll
    for (int q = 0; q < 6; ++q) A64 = cmul(A64, A64);
    __syncthreads();
    x = (f32x2){0.f, 0.f};
    if (d == 0) { for (int s = 0; s < seg; ++s) x = cmul(A64, x) + es[s * 64 + p]; } else { for (int s = 7; s > seg; --s) x = cmul(A64, x) + es[s * 64 + p]; }
    const int nre = d * 128 + p, nim = nre + 64;
#pragma unroll 8
    for (int i = 0; i < 64; ++i) { const int c = c0 + cs * i, cc = b * 512 + c; const float* e = Eb + (size_t)c * 4096;
        X2[((size_t)cc * 16 + (nre >> 4)) * 256 + g * 16 + (nre & 15)] = (bf16)f2bf(x.x); X2[((size_t)cc * 16 + (nim >> 4)) * 256 + g * 16 + (nim & 15)] = (bf16)f2bf(x.y);
        x = cmul(A16, x) + (f32x2){e[0], e[64]}; }
    __syncthreads();
}

struct RwkvCtx { const bf16* Prkv; const bf16* DA; float mur, muk, muv, kkw, kaw, rkw; int d, b, h; };
__device__ __forceinline__ RwkvCtx rwkv_ctx(const Args& A, GAS unsigned char* ws_, int l, int d, int b, int h, int lane) {
    RwkvCtx c; c.Prkv = (const bf16*)(ws_ + WS_PRKV); c.DA = (const bf16*)(ws_ + WS_DA); c.d = d; c.b = b; c.h = h;
    const float* mu = A.in[lnd(I_MURKV)] + ((size_t)l * 2 + d) * 768 + h * 64 + lane; c.mur = mu[0]; c.muk = mu[256]; c.muv = mu[512];
    c.kkw = A.in[lnd(I_KK)][(size_t)l * 256 + h * 64 + lane]; c.kaw = A.in[lnd(I_KA)][(size_t)l * 256 + h * 64 + lane]; c.rkw = A.in[lnd(I_RK)][(size_t)l * 256 + h * 64 + lane];
    return c;
}
__device__ __forceinline__ void rwkv_load_prev(const RwkvCtx& c, int tau, float& ppr, float& ppk, float& ppv, int lane) {
    if (tau == 0) { ppr = 0.f; ppk = 0.f; ppv = 0.f; return; }
    const int s = c.d ? SEQ - tau : tau - 1; const bf16* p = c.Prkv + (size_t)(c.b * SEQ + s) * 768 + c.h * 64 + lane; ppr = bf2f(p[0]); ppk = bf2f(p[256]); ppv = bf2f(p[512]);
}
__device__ __forceinline__ void rwkv_step_ops(const RwkvCtx& c, int tau, float& ppr, float& ppk, float& ppv, float& r, float& k2, float& v, float& kk, float& a, float& dec, int lane) {
    const int s = c.d ? SEQ - 1 - tau : tau; const size_t m = (size_t)c.b * SEQ + s;
    const bf16* p = c.Prkv + m * 768 + c.h * 64 + lane; const float pr = bf2f(p[0]), pk = bf2f(p[256]), pv = bf2f(p[512]);
    const bf16* q = c.DA + m * 1280 + c.d * 256 + c.h * 64 + lane; dec = bf2f(q[0]); a = bf2f(q[512]);
    r = pr + (ppr - pr) * c.mur; const float k = pk + (ppk - pk) * c.muk; v = pv + (ppv - pv) * c.muv; ppr = pr; ppk = pk; ppv = pv;
    kk = k * c.kkw; const float nrm = wave_sum(kk * kk); kk *= rsqrtf(nrm + 1e-12f);
    k2 = k * (1.0f + (a - 1.0f) * c.kaw);
}
__device__ __forceinline__ void rwkv_prep_block(const RwkvCtx& c, int tau0, float& ppr, float& ppk, float& ppv, LAS float* ob, int lane) {
#pragma unroll 1
    for (int st = 0; st < 8; ++st) { float r, k2, v, kk, a, dec; rwkv_step_ops(c, tau0 + st, ppr, ppk, ppv, r, k2, v, kk, a, dec, lane);
        LAS float* o = ob + st * 384; o[lane] = dec; o[64 + lane] = -kk; o[128 + lane] = kk * a; o[192 + lane] = k2; o[256 + lane] = r; o[320 + lane] = v; }
}
__device__ __forceinline__ void rwkv_phase1(const Args& A, GAS unsigned char* ws_, int l, LAS unsigned char* lds, int wave, int lane, int bid, int G) {
    float* PQP = (float*)(ws_ + WS_PQP); float* PQQ = (float*)(ws_ + WS_PQQ);
    LAS float* ob = (LAS float*)(lds + wave * 12288);
    for (int unit = bid * 8 + wave; unit < 2048; unit += G * 8) {
        const int chain = unit >> 7, c = unit & 127, d = chain >> 3, b = (chain >> 2) & 1, h = chain & 3;
        const RwkvCtx cx = rwkv_ctx(A, ws_, l, d, b, h, lane);
        float P[64], Q[64];
#pragma unroll
        for (int j = 0; j < 64; ++j) { P[j] = (j == lane) ? 1.f : 0.f; Q[j] = 0.f; }
        float ppr, ppk, ppv; rwkv_load_prev(cx, c * 64, ppr, ppk, ppv, lane);
        for (int blk = 0; blk < 8; ++blk) {
            rwkv_prep_block(cx, c * 64 + blk * 8, ppr, ppk, ppv, ob, lane);
            LDS_FENCE();
#pragma unroll 1
            for (int st = 0; st < 8; ++st) { const LAS float* o = ob + st * 384; const float vi = o[320 + lane];
                float sp0 = 0.f, sp1 = 0.f, sq0 = 0.f, sq1 = 0.f;
#pragma unroll
                for (int jj = 0; jj < 16; ++jj) { const f32x4 ka = *(const LAS f32x4*)(o + 64 + 4 * jj);
                    sp0 += P[4 * jj] * ka.x; sp1 += P[4 * jj + 1] * ka.y; sp0 += P[4 * jj + 2] * ka.z; sp1 += P[4 * jj + 3] * ka.w;
                    sq0 += Q[4 * jj] * ka.x; sq1 += Q[4 * jj + 1] * ka.y; sq0 += Q[4 * jj + 2] * ka.z; sq1 += Q[4 * jj + 3] * ka.w; }
                const float saP = sp0 + sp1, saQ = sq0 + sq1;
#pragma unroll
                for (int jj = 0; jj < 16; ++jj) { const f32x4 w = *(const LAS f32x4*)(o + 4 * jj), kb = *(const LAS f32x4*)(o + 128 + 4 * jj), kv = *(const LAS f32x4*)(o + 192 + 4 * jj);
#pragma unroll
                    for (int e = 0; e < 4; ++e) { P[4 * jj + e] = P[4 * jj + e] * w[e] + saP * kb[e]; Q[4 * jj + e] = Q[4 * jj + e] * w[e] + (saQ * kb[e] + vi * kv[e]); } }
            }
            LDS_FENCE();
        }
        float* pp = PQP + (size_t)unit * 4096 + lane * 64; float* qq = PQQ + (size_t)unit * 4096 + lane * 64;
#pragma unroll
        for (int jj = 0; jj < 16; ++jj) { *(f32x4*)(pp + 4 * jj) = (f32x4){P[4 * jj], P[4 * jj + 1], P[4 * jj + 2], P[4 * jj + 3]}; *(f32x4*)(qq + 4 * jj) = (f32x4){Q[4 * jj], Q[4 * jj + 1], Q[4 * jj + 2], Q[4 * jj + 3]}; }
    }
}
__device__ __forceinline__ void rwkv_carry(const Args& A, GAS unsigned char* ws_, LAS unsigned char* lds, int tid, int wave, int lane, int j) {
    const float* PQP = (const float*)(ws_ + WS_PQP); float* PQQ = (float*)(ws_ + WS_PQQ);
    const int chain = j >> 2, rg = j & 3; LAS float* Sl = (LAS float*)lds;
    for (int i = tid; i < 16 * 68; i += NTHR) Sl[i] = 0.f;
    __syncthreads();
    const int li = lane & 15, lq = lane >> 4, nt = wave;
    float bN[16]; f32x4 qN = {0.f, 0.f, 0.f, 0.f};
    if (wave < 4) { const float* Pc = PQP + (size_t)(chain * 128) * 4096; const float* Qc = PQQ + (size_t)(chain * 128) * 4096;
#pragma unroll
        for (int kk = 0; kk < 16; ++kk) bN[kk] = Pc[(4 * kk + lq) * 64 + 16 * nt + li];
#pragma unroll
        for (int e = 0; e < 4; ++e) qN[e] = Qc[(rg * 16 + 4 * lq + e) * 64 + 16 * nt + li]; }
    for (int c = 0; c < 127; ++c) {
        f32x4 acc = qN; float bC[16];
        if (wave < 4) {
#pragma unroll
            for (int kk = 0; kk < 16; ++kk) bC[kk] = bN[kk];
            if (c + 1 < 127) { const float* Pc = PQP + (size_t)(chain * 128 + c + 1) * 4096; const float* Qc = PQQ + (size_t)(chain * 128 + c + 1) * 4096;
#pragma unroll
                for (int kk = 0; kk < 16; ++kk) bN[kk] = Pc[(4 * kk + lq) * 64 + 16 * nt + li];
#pragma unroll
                for (int e = 0; e < 4; ++e) qN[e] = Qc[(rg * 16 + 4 * lq + e) * 64 + 16 * nt + li]; }
#pragma unroll
            for (int kk = 0; kk < 16; ++kk) acc = __builtin_amdgcn_mfma_f32_16x16x4f32(Sl[li * 68 + 4 * kk + lq], bC[kk], acc, 0, 0, 0);
            float* Qo = PQQ + (size_t)(chain * 128 + c) * 4096;
#pragma unroll
            for (int e = 0; e < 4; ++e) Qo[(rg * 16 + 4 * lq + e) * 64 + 16 * nt + li] = acc[e];
        }
        __syncthreads();
        if (wave < 4) {
#pragma unroll
            for (int e = 0; e < 4; ++e) Sl[(4 * lq + e) * 68 + 16 * nt + li] = acc[e]; }
        __syncthreads();
    }
}
__device__ __forceinline__ void rwkv_phase3(const Args& A, GAS unsigned char* ws_, int l, LAS unsigned char* lds, int wave, int lane, int bid, int G) {
    const float* PQQ = (const float*)(ws_ + WS_PQQ); float* YS = (float*)(ws_ + WS_YSC);
    LAS float* ob = (LAS float*)(lds + wave * 12288);
    for (int unit = bid * 8 + wave; unit < 2048; unit += G * 8) {
        const int chain = unit >> 7, c = unit & 127, d = chain >> 3, b = (chain >> 2) & 1, h = chain & 3;
        const RwkvCtx cx = rwkv_ctx(A, ws_, l, d, b, h, lane);
        float S[64];
        if (c == 0) {
#pragma unroll
            for (int j = 0; j < 64; ++j) S[j] = 0.f;
        } else { const float* qq = PQQ + (size_t)(unit - 1) * 4096 + lane * 64;
#pragma unroll
            for (int jj = 0; jj < 16; ++jj) { const f32x4 t = *(const f32x4*)(qq + 4 * jj); S[4 * jj] = t.x; S[4 * jj + 1] = t.y; S[4 * jj + 2] = t.z; S[4 * jj + 3] = t.w; } }
        float ppr, ppk, ppv; rwkv_load_prev(cx, c * 64, ppr, ppk, ppv, lane);
        for (int blk = 0; blk < 8; ++blk) {
            rwkv_prep_block(cx, c * 64 + blk * 8, ppr, ppk, ppv, ob, lane);
            LDS_FENCE();
#pragma unroll 1
            for (int st = 0; st < 8; ++st) { const LAS float* o = ob + st * 384; const float vi = o[320 + lane];
                float s0 = 0.f, s1 = 0.f, s2 = 0.f, s3 = 0.f;
#pragma unroll
                for (int jj = 0; jj < 16; ++jj) { const f32x4 ka = *(const LAS f32x4*)(o + 64 + 4 * jj); s0 += S[4 * jj] * ka.x; s1 += S[4 * jj + 1] * ka.y; s2 += S[4 * jj + 2] * ka.z; s3 += S[4 * jj + 3] * ka.w; }
                const float sa = (s0 + s1) + (s2 + s3);
                float y0 = 0.f, y1 = 0.f, y2 = 0.f, y3 = 0.f;
#pragma unroll
                for (int jj = 0; jj < 16; ++jj) { const f32x4 w = *(const LAS f32x4*)(o + 4 * jj), kb = *(const LAS f32x4*)(o + 128 + 4 * jj), kv = *(const LAS f32x4*)(o + 192 + 4 * jj), rr = *(const LAS f32x4*)(o + 256 + 4 * jj);
#pragma unroll
                    for (int e = 0; e < 4; ++e) S[4 * jj + e] = S[4 * jj + e] * w[e] + (sa * kb[e] + vi * kv[e]);
                    y0 += S[4 * jj] * rr.x; y1 += S[4 * jj + 1] * rr.y; y2 += S[4 * jj + 2] * rr.z; y3 += S[4 * jj + 3] * rr.w; }
                const int tau = c * 64 + blk * 8 + st, s = d ? SEQ - 1 - tau : tau;
                YS[((size_t)d * T + (size_t)b * SEQ + s) * 256 + h * 64 + lane] = (y0 + y1) + (y2 + y3);
            }
            LDS_FENCE();
        }
    }
}
__device__ __forceinline__ void rwkv_post(const Args& A, GAS unsigned char* ws_, int l, int lane, int gw, int NGW) {
    const float* YS = (const float*)(ws_ + WS_YSC); const bf16* DA = (const bf16*)(ws_ + WS_DA); bf16* Y = (bf16*)(ws_ + WS_Y);
    for (int it = gw; it < T * 4; it += NGW) { const int m = it >> 2, h = it & 3, b = m >> 13, s = m & (SEQ - 1), hj = h * 64 + lane;
        const float y = YS[(size_t)m * 256 + hj] + YS[((size_t)T + m) * 256 + hj];
        const float mu = wave_sum(y) * (1.f / 64.f), dy = y - mu, var = wave_sum(dy * dy) * (1.f / 64.f);
        const float yn = dy * rsqrtf(var + GN_EPS) * A.in[lnd(I_GNG)][(size_t)l * 256 + hj] + A.in[lnd(I_GNB)][(size_t)l * 256 + hj];
        float bonus = 0.f;
#pragma unroll
        for (int d = 0; d < 2; ++d) { const RwkvCtx cx = rwkv_ctx(A, ws_, l, d, b, h, lane); const int tau = d ? SEQ - 1 - s : s; float ppr, ppk, ppv; rwkv_load_prev(cx, tau, ppr, ppk, ppv, lane);
            float r, k2, v, kk, a, dec; rwkv_step_ops(cx, tau, ppr, ppk, ppv, r, k2, v, kk, a, dec, lane);
            bonus += wave_sum(r * k2 * cx.rkw) * v; }
        const float g = bf2f(DA[(size_t)m * 1280 + 1024 + hj]);
        Y[(size_t)m * 1280 + 256 + hj] = (bf16)f2bf((yn + bonus) * g); }
}

constexpr int PH_PER_LAYER = 12, N_PHASES = 1 + PH_PER_LAYER * NL;
#define Hf (A.out)
#define WSP(type, off) ((type*)(ws_ + (off)))
#define Hb WSP(bf16, WS_HB)
#define Pu WSP(bf16, WS_PU)
#define Prkv WSP(bf16, WS_PRKV)
#define Pconv WSP(bf16, WS_PCONV)
#define Pfft WSP(bf16, WS_PFFT)
#define PL WSP(bf16, WS_PL)
#define LA WSP(bf16, WS_LA)
#define DA WSP(bf16, WS_DA)
#define Y WSP(bf16, WS_Y)
#define YA WSP(bf16, WS_YA)
#define X2 WSP(bf16, WS_X)
#define ACT WSP(bf16, WS_ACT)
#define E WSP(float, WS_E)
#define FM WSP(f32x2, WS_FM)
#define WIN WSP(const bf16, WS_WB + WB_WIN)
#define WL2 WSP(const bf16, WS_WB + WB_WL2)
#define S5E WSP(const bf16, WS_WB + WB_S5E)
#define S5Y WSP(const bf16, WS_WB + WB_S5Y)
#define GLU WSP(const bf16, WS_WB + WB_GLU)
#define WOUT WSP(const bf16, WS_WB + WB_WOUT)
#define W13 WSP(const bf16, WS_WB + WB_W13)
#define W2 WSP(const bf16, WS_WB + WB_W2)
#define LB WSP(const f32x2, WS_WB + WB_SC + SC_LB)
#define IN(k) (lo <= (k) && (k) < hi)
#define SEAM(k) do { if (IN(k) && IN((k) + 1)) grid.sync(); } while (0)
#define PH_TID() int wave = wave0, bid = blockIdx.x, G = gridDim.x; GAS unsigned char* ws_ = (GAS unsigned char*)A.ws; asm volatile("" : "+s"(wave), "+s"(bid), "+s"(G), "+s"(ws_)); int lane = __builtin_amdgcn_mbcnt_hi(~0u, __builtin_amdgcn_mbcnt_lo(~0u, 0u)); asm volatile("" : "+v"(lane)); const int tid = wave * 64 + lane, gw = bid * 8 + wave, NGW = G * 8; (void)tid; (void)gw; (void)NGW
template <int l>
__device__ __forceinline__ void layer_body(const Args& A, LAS unsigned char* lds, cg::grid_group& grid, const int wave0, const int lo, const int hi) {
    constexpr int p0 = 1 + PH_PER_LAYER * l;
        if (IN(p0 + 0)) { PH_TID();
            pg8::StaticOrder S; S.init(T, 3072, G, bid); EpiP Ep{Pu, Prkv, Pconv, Pfft, PL};
            pg8::gemm_phase<EpiP, pg8::StaticOrder, true, true>(lds, pg8::mk_gemm(Hb, WIN, T, 3072, 1024), S, Ep, wave);
            prep_s5_b(A, ws_, l, lane, gw, NGW);
        }
        SEAM(p0 + 0);
        if (IN(p0 + 1)) { PH_TID();
            for (int m = gw; m < T; m += NGW) { lora_act_row(PL, LA, m, lane); conv_row(Pconv, A.in[lnd(I_CONVW)] + (size_t)l * 768, Y, m, lane); }
            prep_s5_c(A, ws_, l, lane, gw, NGW);
            __syncthreads();
            fft_step1(Pfft, FM, lds, tid, bid, G);
            {
                pg8::Gemm g = pg8::mk_gemm(Pu, S5E, 1024, 4096, 256); g.a_rs = 8192; g.a_k16 = 512; g.a_kstep = 2048; g.a_pn = 32;
                pg8::StaticOrder S; S.init(1024, 4096, G, bid); EpiE Ee{E};
                pg8::gemm_phase<EpiE, pg8::StaticOrder, false, true, true>(lds, g, S, Ee, wave);
            }
        }
        SEAM(p0 + 1);
        if (IN(p0 + 2)) { PH_TID();
            {   pg8::StaticOrder S; S.init(T, 1280, G, bid); EpiL2 El{DA, A.in[lnd(I_W0)] + (size_t)l * 512, A.in[lnd(I_A0)] + (size_t)l * 512};
                pg8::gemm_phase<EpiL2, pg8::StaticOrder, true, true>(lds, pg8::mk_gemm(LA, WL2, T, 1280, 512), S, El, wave); }
            if (bid >= G - 64) s5_carry(E, X2, LB, lds, bid - (G - 64), tid);
            __syncthreads();
            fft_step3(FM, Y, lds, tid, bid, G);
        }
        SEAM(p0 + 2);
        if (IN(p0 + 3)) { PH_TID();
            rwkv_phase1(A, ws_, l, lds, wave, lane, bid, G);
            __syncthreads();
            {
                pg8::Gemm g = pg8::mk_gemm(Pu, S5Y, 1024, 4096, 512); g.a_rs = 8192; g.a_k16 = 512; g.a_kstep = 2048; g.a_pn = 32; g.ksplit = 4; g.a_delta = (long)((const char*)X2 - (const char*)Pu) - 4 * 2048;
                pg8::StaticOrder S; S.init(1024, 4096, G, bid); EpiS5Y Ey{YA};
                pg8::gemm_phase<EpiS5Y, pg8::StaticOrder, false, true, true>(lds, g, S, Ey, wave);
            }
        }
        SEAM(p0 + 3);
        if (IN(p0 + 4)) { PH_TID();
            if (bid < 64) rwkv_carry(A, ws_, lds, tid, wave, lane, bid);
            else { pg8::StaticOrder S; S.init(T, 256, G, bid < 128 ? bid - 64 : (1 << 24)); EpiGLU Eg{YA, Y, A.in[lnd(I_GLUB)] + (size_t)l * 256};
                pg8::gemm_phase<EpiGLU, pg8::StaticOrder, false, true>(lds, pg8::mk_gemm(YA, GLU, T, 256, 256), S, Eg, wave); }
        }
        SEAM(p0 + 4);
        if (IN(p0 + 5)) { PH_TID(); rwkv_phase3(A, ws_, l, lds, wave, lane, bid, G); }
        SEAM(p0 + 5);
        if (IN(p0 + 6)) { PH_TID(); rwkv_post(A, ws_, l, lane, gw, NGW); }
        SEAM(p0 + 6);
        if (IN(p0 + 7)) { PH_TID(); pg8::StaticOrder S; S.init(T, 1024, G, bid); EpiRes Er{Hf};
            pg8::gemm_phase<EpiRes, pg8::StaticOrder, false, true>(lds, pg8::mk_gemm(Y, WOUT, T, 1024, 1280), S, Er, wave); }
        SEAM(p0 + 7);
        if (IN(p0 + 8)) { PH_TID(); for (int m = gw; m < T; m += NGW) ln_row(Hf + (size_t)m * D, A.in[lnd(I_LN1G)] + (size_t)l * D, A.in[lnd(I_LN1B)] + (size_t)l * D, Hf + (size_t)m * D, Hb + (size_t)m * D, lane); }
        SEAM(p0 + 8);
        if (IN(p0 + 9)) { PH_TID(); pg8::StaticOrder S; S.init(T, 5632, G, bid); EpiSwi Es{ACT};
            pg8::gemm_phase<EpiSwi, pg8::StaticOrder, true, true>(lds, pg8::mk_gemm(Hb, W13, T, 5632, 1024), S, Es, wave); }
        SEAM(p0 + 9);
        if (IN(p0 + 10)) { PH_TID(); pg8::StaticOrder S; S.init(T, 1024, G, bid); EpiRes Er{Hf};
            pg8::gemm_phase<EpiRes, pg8::StaticOrder, false, true>(lds, pg8::mk_gemm(ACT, W2, T, 1024, DFF), S, Er, wave); }
        SEAM(p0 + 10);
        if (IN(p0 + 11)) { PH_TID();
            for (int m = gw; m < T; m += NGW) ln_row(Hf + (size_t)m * D, A.in[lnd(I_LN2G)] + (size_t)l * D, A.in[lnd(I_LN2B)] + (size_t)l * D, Hf + (size_t)m * D, Hb + (size_t)m * D, lane);
            if (l + 1 < NL) prep_weights(A, ws_, l + 1, lds, wave, lane, gw, NGW);
        }
        SEAM(p0 + 11);
}
__global__ void __launch_bounds__(NTHR, 2) hphe_fwd(Args A) {
    __builtin_assume(__builtin_amdgcn_workitem_id_y() == 0); __builtin_assume(__builtin_amdgcn_workitem_id_z() == 0);
    extern __shared__ __attribute__((aligned(16))) unsigned char lds_raw[];
    LAS unsigned char* lds = (LAS unsigned char*)lds_raw;
    cg::grid_group grid = cg::this_grid();
    const int wave0 = __builtin_amdgcn_readfirstlane(threadIdx.x >> 6);
    const int lo = A.ph_lo, hi = A.ph_hi;

    if (IN(0)) { PH_TID();
        for (int m = gw; m < T; m += NGW) ln_row(A.in[lnd(I_X)] + (size_t)m * D, A.in[lnd(I_LN0G)], A.in[lnd(I_LN0B)], Hf + (size_t)m * D, Hb + (size_t)m * D, lane);
        prep_weights(A, ws_, 0, lds, wave, lane, gw, NGW);
    }
    SEAM(0);
    layer_body<0>(A, lds, grid, wave0, lo, hi);
    layer_body<1>(A, lds, grid, wave0, lo, hi);
    static_assert(NL == 2, "two layers instantiated");
#undef IN
#undef SEAM
}

#ifndef MK_MULTI
#define MK_MULTI 0
#endif
extern "C" void kernel_launch(void* const* d_in, const int* in_sizes, int n_in, void* d_out, int out_size, void* d_ws, size_t ws_size, hipStream_t stream) {
    static int grid = 0;
    if (grid == 0) {
        if (n_in != N_IN || out_size != T * D || ws_size < WS_END) { fprintf(stderr, "kernel_launch: unexpected problem shape (n_in %d out %d ws %zu)\n", n_in, out_size, ws_size); grid = -1; return; }
        int dev = 0, cus = 0, per_cu = 0;
        hipGetDevice(&dev); hipDeviceGetAttribute(&cus, hipDeviceAttributeMultiprocessorCount, dev);
        hipFuncSetAttribute((const void*)hphe_fwd, hipFuncAttributeMaxDynamicSharedMemorySize, LDS_BYTES);
        hipOccupancyMaxActiveBlocksPerMultiprocessor(&per_cu, (const void*)hphe_fwd, NTHR, LDS_BYTES);
        (void)hipGetLastError();
        if (per_cu < 1) { fprintf(stderr, "kernel_launch: occupancy query says 0 blocks per CU\n"); grid = -1; return; }
        grid = cus;
    }
    if (grid < 0) return;
    Args a{};
    for (int i = 0; i < N_IN; ++i) a.in[i] = (const float*)d_in[i];
    a.out = (float*)d_out; a.ws = (unsigned char*)d_ws;
#if MK_MULTI
    for (int p = 0; p < N_PHASES; ++p) { a.ph_lo = p; a.ph_hi = p + 1; hipLaunchKernelGGL(hphe_fwd, dim3(grid), dim3(NTHR), LDS_BYTES, stream, a); }
#else
    a.ph_lo = 0; a.ph_hi = N_PHASES;
    void* args[] = {&a};
    hipError_t e = hipLaunchCooperativeKernel((const void*)hphe_fwd, dim3(grid), dim3(NTHR), args, LDS_BYTES, stream);
    if (e != hipSuccess) fprintf(stderr, "cooperative launch failed: %s (grid %d)\n", hipGetErrorString(e), grid);
#endif
}
```

```cpp
#include <hip/hip_runtime.h>
#include <hip/hip_cooperative_groups.h>
#include <cstdio>
#include <cstdint>
namespace cg = cooperative_groups;
namespace pg8 {
#define PG8_LAS __attribute__((address_space(3)))
typedef unsigned short bf16_t;
typedef short bf16x8 __attribute__((ext_vector_type(8)));
typedef float f32x4 __attribute__((ext_vector_type(4)));
typedef unsigned u32x4 __attribute__((ext_vector_type(4)));
constexpr int BM = 256, BK = 64, HALF = 128, HTB = HALF * BK * 2  , STAGE_BYTES = 8 * HTB, NXCD = 8, WGM = 8;

__host__ __device__ __forceinline__ int lds_byte(int r, int c) { const int st = (r >> 4) * 2 + (c >> 5), rr = r & 15, cc = c & 31, ob = rr * 64 + cc * 2; return st * 1024 + (ob ^ (((ob >> 9) & 1) << 5)); }
__host__ __device__ __forceinline__ void stage_rc(int b, int& R, int& C) { const int st = b / 1024, sb = b % 1024, swz = sb ^ (((sb >> 9) & 1) << 5); R = (st >> 1) * 16 + swz / 64; C = (st & 1) * 32 + (swz % 64) / 2; }
__host__ __device__ __forceinline__ int perm32(int rho) { const int n = rho >> 4, i = rho & 15; return 8 * (i >> 2) + 4 * n + (i & 3); }

struct Unit { int pm, pn; };
struct Gemm { const bf16_t* A; const bf16_t* Bt; int M, N, K; int a_rs, a_k16, a_kstep, a_pn, ksplit; long a_delta; };
__host__ __device__ __forceinline__ Gemm mk_gemm(const bf16_t* A, const bf16_t* Bt, int M, int N, int K) { Gemm g; g.A = A; g.Bt = Bt; g.M = M; g.N = N; g.K = K; g.a_rs = 2 * K; g.a_k16 = 32; g.a_kstep = 128; g.a_pn = 0; g.ksplit = 1 << 30; g.a_delta = 0; return g; }
struct StaticOrder {
    int nM, nN, nwg, G, c;
    __host__ __device__ void init(int M, int N, int G_, int c_) { nM = M / BM; nN = N / BM; nwg = nM * nN; G = G_; c = c_; }
    __host__ __device__ bool next(int i, Unit& u) const {
        const long L = (long)i * G + c; if (L >= nwg) return false;
        int wgid = (int)L; { const int q = nwg / NXCD, r = nwg % NXCD, xcd = wgid % NXCD, off = wgid / NXCD; wgid = (xcd < r ? xcd * (q + 1) : r * (q + 1) + (xcd - r) * q) + off; }
        const int nig = WGM * nN, gid = wgid / nig, fm = gid * WGM, gsz = (nM - fm) < WGM ? (nM - fm) : WGM;
        u.pm = fm + ((wgid % nig) % gsz); u.pn = (wgid % nig) / gsz; return true;
    }
    __device__ __forceinline__ void a_ready(const Unit&) const {}
    __device__ __forceinline__ void done(const Unit&) const {}
};
__device__ __forceinline__ unsigned cvt_pk_bf16(float lo, float hi) { unsigned r; asm volatile("v_cvt_pk_bf16_f32 %0, %1, %2" : "=v"(r) : "v"(lo), "v"(hi)); return r; }
template <class Epi, class Sched, bool ALIGN_EPI = false, bool SP2 = false, bool GEN = false>
__device__ __forceinline__ void gemm_phase(PG8_LAS unsigned char* lds, const Gemm g, const Sched& S, const Epi& E, int wave_id) {
    int lane_l = __builtin_amdgcn_mbcnt_hi(~0u, __builtin_amdgcn_mbcnt_lo(~0u, 0u)); asm volatile("" : "+v"(lane_l)); const int tid_l = wave_id * 64 + lane_l;
    const int tid = tid_l, wid = wave_id, lane = lane_l, wr = wid >> 2, wc = wid & 3, fr = lane & 15, fq = lane >> 4;
    const int K = g.K, nt = K / BK;
    unsigned voffA[2], voffB[2];
#pragma unroll
    for (int i = 0; i < 2; ++i) { int R, C; stage_rc(tid * 16 + i * 8192, R, C); const int Rb = Epi::PERM ? ((R & ~31) + perm32(R & 31)) : R;
        voffA[i] = GEN ? (unsigned)(R * g.a_rs + (C >> 4) * g.a_k16 + (C & 15) * 2) : (unsigned)(R * K + C) * 2u; voffB[i] = (unsigned)(Rb * K + C) * 2u; }
    const size_t kstep = (size_t)(BK * 2);
    const size_t hstep = (size_t)HALF * K * 2;
    const size_t tstep = 2 * hstep;
    const size_t hstepA = GEN ? (size_t)HALF * g.a_rs : hstep, tstepA = 2 * hstepA; const int ksplit = g.ksplit; const long a_delta = g.a_delta; const size_t akstep = GEN ? (size_t)g.a_kstep : kstep;
#define PG8_AP(base, kt) (GEN ? ((base) + (size_t)(kt) * akstep + ((kt) >= ksplit ? a_delta : 0l)) : ((base) + (size_t)(kt) * kstep))
    const unsigned ldsw = (unsigned)wid * 1024u;
    const int aoff = lds_byte(wr * 64 + fr, fq * 8), boff = lds_byte(wc * 32 + fr, fq * 8);
#define PG8_SA(b, h) (((b) * 2 + (h)) * HTB)
#define PG8_SB(b, h) ((4 + (b) * 2 + (h)) * HTB)
#define PG8_STAGE(bufoff, gbase, voff) do { _Pragma("unroll") for (int _i = 0; _i < 2; ++_i) \
        __builtin_amdgcn_global_load_lds((const unsigned*)((const char*)(gbase) + (voff)[_i]), (PG8_LAS unsigned*)(lds + (bufoff) + ldsw + _i * 8192), 16, 0, 0); } while (0)
#define PG8_LDA(dst, b, h) do { _Pragma("unroll") for (int m = 0; m < 4; ++m) _Pragma("unroll") for (int k = 0; k < 2; ++k) dst[m][k] = *(const PG8_LAS bf16x8*)(lds + PG8_SA(b, h) + aoff + m * 2048 + k * 1024); } while (0)
#define PG8_LDB(dst, b, h) do { _Pragma("unroll") for (int n = 0; n < 2; ++n) _Pragma("unroll") for (int k = 0; k < 2; ++k) dst[n][k] = *(const PG8_LAS bf16x8*)(lds + PG8_SB(b, h) + boff + n * 2048 + k * 1024); } while (0)
#define PG8_MMA(ai, bj, At, Bt) do { __builtin_amdgcn_s_setprio(1); _Pragma("unroll") for (int m = 0; m < 4; ++m) _Pragma("unroll") for (int n = 0; n < 2; ++n) _Pragma("unroll") for (int k = 0; k < 2; ++k) \
        acc[ai][bj][m][n] = __builtin_amdgcn_mfma_f32_16x16x32_bf16(Bt[n][k], At[m][k], acc[ai][bj][m][n], 0, 0, 0); __builtin_amdgcn_s_setprio(0); } while (0)
#define PG8_WAIT_V(n) asm volatile("s_waitcnt vmcnt(" #n ")" ::: "memory")
#define PG8_WAIT_L(n) asm volatile("s_waitcnt lgkmcnt(" #n ")" ::: "memory")
#define PG8_BAR __builtin_amdgcn_s_barrier()
#define PG8_SCHED __builtin_amdgcn_sched_barrier(0)
    Unit cur, nxt; int ui = 0;
    if (!S.next(0, cur)) return;
    f32x4 acc[2][2][4][2];
#pragma unroll
    for (int a = 0; a < 2; ++a)
#pragma unroll
        for (int b = 0; b < 2; ++b)
#pragma unroll
            for (int m = 0; m < 4; ++m)
#pragma unroll
                for (int n = 0; n < 2; ++n) acc[a][b][m][n] = (f32x4){0.f, 0.f, 0.f, 0.f};
    bf16x8 At[4][2], B0[2][2], B1[2][2];
    const char* cA = (const char*)g.A + (size_t)cur.pm * tstepA + (GEN ? (size_t)cur.pn * g.a_pn : (size_t)0); const char* cB = (const char*)g.Bt + (size_t)cur.pn * tstep;
    S.a_ready(cur);
    if constexpr (SP2) {
        PG8_STAGE(PG8_SB(0, 0), cB, voffB); PG8_STAGE(PG8_SB(0, 1), cB + hstep, voffB); PG8_STAGE(PG8_SA(0, 0), PG8_AP(cA, 0), voffA); PG8_STAGE(PG8_SA(0, 1), PG8_AP(cA, 0) + hstepA, voffA);
        if (wr == 1) PG8_BAR;
        PG8_WAIT_V(2); PG8_BAR;
        PG8_STAGE(PG8_SB(1, 0), cB + kstep, voffB); PG8_STAGE(PG8_SA(1, 0), PG8_AP(cA, 1), voffA); PG8_STAGE(PG8_SB(1, 1), cB + hstep + kstep, voffB);
        PG8_WAIT_V(6); PG8_BAR;
    } else {
        PG8_STAGE(PG8_SB(0, 0), cB, voffB); PG8_STAGE(PG8_SA(0, 0), PG8_AP(cA, 0), voffA); PG8_STAGE(PG8_SB(0, 1), cB + hstep, voffB); PG8_STAGE(PG8_SA(0, 1), PG8_AP(cA, 0) + hstepA, voffA);
        if (wr == 1) PG8_BAR;
        PG8_WAIT_V(4); PG8_BAR;
        PG8_STAGE(PG8_SB(1, 0), cB + kstep, voffB); PG8_STAGE(PG8_SA(1, 0), PG8_AP(cA, 1), voffA); PG8_STAGE(PG8_SB(1, 1), cB + hstep + kstep, voffB);
        PG8_WAIT_V(6); PG8_BAR;
    }
    for (;;) {
        const bool has_next = S.next(ui + 1, nxt);
        const char* nA = has_next ? (const char*)g.A + (size_t)nxt.pm * tstepA + (GEN ? (size_t)nxt.pn * g.a_pn : (size_t)0) : cA; const char* nB = has_next ? (const char*)g.Bt + (size_t)nxt.pn * tstep : cB;
        for (int t = 0; t < nt; t += 2) {
            const bool last = (t == nt - 2);
            const char* a1 = PG8_AP(cA, t + 1);
            const char* a2 = last ? PG8_AP(nA, 0) : PG8_AP(cA, t + 2); const char* b2 = last ? nB : cB + (size_t)(t + 2) * kstep;
            const char* a3 = last ? PG8_AP(nA, 1) : PG8_AP(cA, t + 3); const char* b3 = b2 + kstep;
            if (last && has_next) S.a_ready(nxt);
            if constexpr (SP2) {
            PG8_LDB(B0, 0, 0); PG8_LDB(B1, 0, 1); PG8_SCHED; PG8_LDA(At, 0, 0); PG8_STAGE(PG8_SA(1, 1), a1 + hstepA, voffA);
            PG8_WAIT_V(8); PG8_WAIT_L(0); PG8_BAR; PG8_MMA(0, 0, At, B0); PG8_MMA(0, 1, At, B1); PG8_BAR; PG8_SCHED;
            PG8_LDA(At, 0, 1); PG8_STAGE(PG8_SB(0, 0), b2, voffB); PG8_STAGE(PG8_SB(0, 1), b2 + hstep, voffB); PG8_STAGE(PG8_SA(0, 0), a2, voffA);
            PG8_WAIT_V(8); PG8_WAIT_L(0); PG8_BAR; PG8_MMA(1, 0, At, B0); PG8_MMA(1, 1, At, B1); PG8_BAR; PG8_SCHED;
            PG8_LDB(B0, 1, 0); PG8_LDB(B1, 1, 1); PG8_SCHED; PG8_LDA(At, 1, 0); PG8_STAGE(PG8_SA(0, 1), a2 + hstepA, voffA);
            PG8_WAIT_V(8); PG8_WAIT_L(0); PG8_BAR; PG8_MMA(0, 0, At, B0); PG8_MMA(0, 1, At, B1); PG8_BAR; PG8_SCHED;
            PG8_LDA(At, 1, 1); PG8_STAGE(PG8_SB(1, 0), b3, voffB); PG8_STAGE(PG8_SB(1, 1), b3 + hstep, voffB); PG8_STAGE(PG8_SA(1, 0), a3, voffA);
            PG8_WAIT_V(8); PG8_WAIT_L(0); PG8_BAR; PG8_MMA(1, 0, At, B0); PG8_MMA(1, 1, At, B1); PG8_BAR; PG8_SCHED;
            } else {
            PG8_LDB(B0, 0, 0); PG8_SCHED; PG8_LDA(At, 0, 0); PG8_STAGE(PG8_SA(1, 1), a1 + hstepA, voffA);
            PG8_WAIT_L(8); PG8_BAR; PG8_WAIT_L(0); PG8_MMA(0, 0, At, B0); PG8_BAR; PG8_SCHED;
            PG8_LDB(B1, 0, 1); PG8_STAGE(PG8_SB(0, 0), b2, voffB);
            PG8_BAR; PG8_WAIT_L(0); PG8_MMA(0, 1, At, B1); PG8_BAR;
            PG8_LDA(At, 0, 1); PG8_STAGE(PG8_SA(0, 0), a2, voffA);
            PG8_BAR; PG8_WAIT_L(0); PG8_MMA(1, 0, At, B0); PG8_BAR; PG8_SCHED;
            PG8_STAGE(PG8_SB(0, 1), b2 + hstep, voffB);
            PG8_WAIT_V(6); PG8_BAR; PG8_MMA(1, 1, At, B1); PG8_BAR;
            PG8_LDB(B0, 1, 0); PG8_SCHED; PG8_LDA(At, 1, 0); PG8_STAGE(PG8_SA(0, 1), a2 + hstepA, voffA);
            PG8_WAIT_L(8); PG8_BAR; PG8_WAIT_L(0); PG8_MMA(0, 0, At, B0); PG8_BAR; PG8_SCHED;
            PG8_LDB(B1, 1, 1); PG8_STAGE(PG8_SB(1, 0), b3, voffB);
            PG8_BAR; PG8_WAIT_L(0); PG8_MMA(0, 1, At, B1); PG8_BAR;
            PG8_LDA(At, 1, 1); PG8_STAGE(PG8_SA(1, 0), a3, voffA);
            PG8_BAR; PG8_WAIT_L(0); PG8_MMA(1, 0, At, B0); PG8_BAR; PG8_SCHED;
            PG8_STAGE(PG8_SB(1, 1), b3 + hstep, voffB);
            PG8_WAIT_V(6); PG8_BAR; PG8_MMA(1, 1, At, B1); PG8_BAR;
            }
        }
        if constexpr (ALIGN_EPI) { if (wr == 0) PG8_BAR; }
        if constexpr (!Epi::AFTER_DRAIN) { E(acc, cur, wr, wc, fr, fq); S.done(cur); }
        if (!has_next) break;
#pragma unroll
        for (int a = 0; a < 2; ++a)
#pragma unroll
            for (int b = 0; b < 2; ++b)
#pragma unroll
                for (int m = 0; m < 4; ++m)
#pragma unroll
                    for (int n = 0; n < 2; ++n) acc[a][b][m][n] = (f32x4){0.f, 0.f, 0.f, 0.f};
        cur = nxt; cA = nA; cB = nB; ++ui;
        if constexpr (ALIGN_EPI) { if (wr == 1) PG8_BAR; }
    }
    PG8_WAIT_V(0);
    if constexpr (!ALIGN_EPI) { if (wr == 0) PG8_BAR; }
    PG8_BAR;
    if constexpr (Epi::AFTER_DRAIN) { E.fused(acc, cur, wr, wc, fr, fq, lds, wid, lane); S.done(cur); }
#undef PG8_AP
#undef PG8_SA
#undef PG8_SB
#undef PG8_STAGE
#undef PG8_LDA
#undef PG8_LDB
#undef PG8_MMA
#undef PG8_WAIT_V
#undef PG8_WAIT_L
#undef PG8_BAR
#undef PG8_SCHED
}
}

#define LAS __attribute__((address_space(3)))
#define GAS __attribute__((address_space(1)))
typedef unsigned short bf16;
typedef float f32x4 __attribute__((ext_vector_type(4)));
typedef float f32x2 __attribute__((ext_vector_type(2)));
typedef unsigned u32x4 __attribute__((ext_vector_type(4)));
typedef unsigned u32x2 __attribute__((ext_vector_type(2)));

constexpr int T = 16384, SEQ = 8192, D = 1024, NL = 2, DFF = 2816, NTHR = 512;
constexpr float LN_EPS = 1e-5f, DN_ALPHA = 1.4142135623730951f, GN_EPS = 64e-5f, DECAY_SCALE = 0.6065306597126334f;
constexpr float FFT_SCALE = 0.0013810679320049757f;
constexpr size_t MiB = (size_t)1 << 20;
constexpr size_t WS_WB = 1 * MiB;
constexpr size_t WB_WIN = 0, WB_WL2 = 6 * MiB, WB_S5E = WB_WL2 + 1280 * 512 * 2, WB_S5Y = WB_S5E + 2 * MiB, WB_GLU = WB_S5Y + 4 * MiB,
                 WB_WOUT = WB_GLU + 131072, WB_W13 = WB_WOUT + 1024 * 1280 * 2, WB_W2 = WB_W13 + (size_t)5632 * 1024 * 2, WB_SC = WB_W2 + (size_t)1024 * 2816 * 2;
constexpr size_t SC_LB = 0, SC_BB = 2 * 16 * 17 * 64 * 8, SC_KT = SC_BB + 2 * 16 * 64 * 16 * 8, SC_END = SC_KT + 16 * 2 * 16 * 256 * 4;
static_assert(WB_SC + SC_END <= 34 * MiB, "weights region");
constexpr size_t WS_HB = 35 * MiB, WS_PRKV = 67 * MiB, WS_PU = 91 * MiB, WS_Y = 99 * MiB, WS_DA = 139 * MiB, WS_PL = 139 * MiB, WS_PCONV = 179 * MiB, WS_PFFT = 203 * MiB,
                 WS_FM = 211 * MiB, WS_X = 171 * MiB, WS_Z = 219 * MiB, WS_QR = 235 * MiB, WS_LA = 35 * MiB, WS_E = 51 * MiB, WS_PQP = 35 * MiB, WS_PQQ = 179 * MiB, WS_YA = 211 * MiB, WS_YSC = 35 * MiB, WS_ACT = 67 * MiB,
                 WS_END = 251 * MiB;
constexpr int LDS_BYTES = 147456;

enum { I_X = 0, I_LN0G, I_LN0B, I_WIN, I_LRE, I_LIM, I_LOGDT, I_BRE, I_BIM, I_CRE, I_CIM, I_S5D, I_GLUW, I_GLUB, I_MURKV, I_MUW, I_MUA, I_MUG, I_W0, I_W1, I_W2, I_A0, I_A1, I_A2,
       I_G1, I_G2, I_KK, I_KA, I_RK, I_GNG, I_GNB, I_CONVW, I_WOUT, I_LN1G, I_LN1B, I_FW1, I_FW3, I_FW2, I_LN2G, I_LN2B, N_IN };
struct Args { const float* in[N_IN]; float* out; unsigned char* ws; int ph_lo, ph_hi; };

__device__ __forceinline__ int lnd(int k) { asm volatile("" : "+s"(k)); return k; }
__device__ __forceinline__ unsigned f2bf(float f) { unsigned u = __builtin_bit_cast(unsigned, f); return (u + 0x7fffu + ((u >> 16) & 1u)) >> 16; }
__device__ __forceinline__ unsigned pk2(float lo, float hi) { return f2bf(lo) | (f2bf(hi) << 16); }
__device__ __forceinline__ float bf2f(unsigned short u) { return __builtin_bit_cast(float, (unsigned)u << 16); }
__device__ __forceinline__ float bflo(unsigned w) { return __builtin_bit_cast(float, w << 16); }
__device__ __forceinline__ float bfhi(unsigned w) { return __builtin_bit_cast(float, w & 0xffff0000u); }
__device__ __forceinline__ float sigm(float x) { return 1.0f / (1.0f + __expf(-x)); }
__device__ __forceinline__ float tanh_(float z) { return 1.0f - 2.0f / (1.0f + __expf(2.0f * z)); }
__device__ __forceinline__ float gelu_tanh(float x) { return 0.5f * x * (1.0f + tanh_(0.7978845608028654f * (x + 0.044715f * x * x * x))); }
__device__ __forceinline__ float wave_sum(float v) {
#pragma unroll
    for (int o = 1; o < 64; o <<= 1) v += __shfl_xor(v, o);
    return v;
}
#define LDS_FENCE() do { asm volatile("s_waitcnt lgkmcnt(0)" ::: "memory"); __builtin_amdgcn_wave_barrier(); } while (0)
__device__ __forceinline__ f32x2 cmul(f32x2 a, f32x2 b) { return (f32x2){a.x * b.x - a.y * b.y, a.x * b.y + a.y * b.x}; }

using pg8::Unit;
#define EPI_ARGS const f32x4 (&acc)[2][2][4][2], const Unit& u, int wr, int wc, int fr, int fq
__device__ __forceinline__ u32x4 pack8(f32x4 a, f32x4 b) { u32x4 w; w.x = pk2(a[0], a[1]); w.y = pk2(a[2], a[3]); w.z = pk2(b[0], b[1]); w.w = pk2(b[2], b[3]); return w; }

struct EpiP {
    static constexpr bool PERM = true, AFTER_DRAIN = false; bf16 *Pu, *Prkv, *Pconv, *Pfft, *PL;
    __device__ __forceinline__ void operator()(EPI_ARGS) const {
        const int pn = u.pn; bf16* base; int ldc, cofs;
        if (pn == 0) { base = Pu; ldc = 256; cofs = 0; } else if (pn < 4) { base = Prkv; ldc = 768; cofs = (pn - 1) * 256; } else if (pn < 7) { base = Pconv; ldc = 768; cofs = (pn - 4) * 256; }
        else if (pn == 7) { base = Pfft; ldc = 256; cofs = 0; } else { base = PL; ldc = 1024; cofs = (pn - 8) * 256; }
#pragma unroll
        for (int ai = 0; ai < 2; ++ai)
#pragma unroll
            for (int m = 0; m < 4; ++m) { const int row = u.pm * 256 + ai * 128 + wr * 64 + m * 16 + fr;
#pragma unroll
                for (int bj = 0; bj < 2; ++bj) *(u32x4*)(base + (size_t)row * ldc + cofs + bj * 128 + wc * 32 + 8 * fq) = pack8(acc[ai][bj][m][0], acc[ai][bj][m][1]); }
    }
};
struct EpiL2 {
    static constexpr bool PERM = true, AFTER_DRAIN = false; bf16* DA; bf16* Yg; const float* w0; const float* a0;
    __device__ __forceinline__ void operator()(EPI_ARGS) const {
        const int pn = u.pn;
#pragma unroll
        for (int bj = 0; bj < 2; ++bj) { const int col = pn * 256 + bj * 128 + wc * 32 + 8 * fq; f32x4 b0 = {0.f, 0.f, 0.f, 0.f}, b1 = b0;
            if (pn < 2) { b0 = *(const f32x4*)(w0 + col); b1 = *(const f32x4*)(w0 + col + 4); } else if (pn < 4) { b0 = *(const f32x4*)(a0 + col - 512); b1 = *(const f32x4*)(a0 + col - 508); }
#pragma unroll
            for (int ai = 0; ai < 2; ++ai)
#pragma unroll
                for (int m = 0; m < 4; ++m) { const int row = u.pm * 256 + ai * 128 + wr * 64 + m * 16 + fr; f32x4 v0 = acc[ai][bj][m][0] + b0, v1 = acc[ai][bj][m][1] + b1;
                    if (pn < 2) {
#pragma unroll
                        for (int e = 0; e < 4; ++e) { v0[e] = __expf(-DECAY_SCALE * sigm(v0[e])); v1[e] = __expf(-DECAY_SCALE * sigm(v1[e])); } }
                    else if (pn < 4) {
#pragma unroll
                        for (int e = 0; e < 4; ++e) { v0[e] = sigm(v0[e]); v1[e] = sigm(v1[e]); } }
                    if (pn < 4) *(u32x4*)(DA + (size_t)row * 1024 + col) = pack8(v0, v1); else *(u32x4*)(Yg + (size_t)row * 1280 + 256 + (col - 1024)) = pack8(v0, v1); } }
    }
};
struct EpiE {
    static constexpr bool PERM = false, AFTER_DRAIN = false; float* E;
    __device__ __forceinline__ void operator()(EPI_ARGS) const {
#pragma unroll
        for (int ai = 0; ai < 2; ++ai)
#pragma unroll
            for (int m = 0; m < 4; ++m) { const int row = u.pm * 256 + ai * 128 + wr * 64 + m * 16 + fr;
#pragma unroll
                for (int bj = 0; bj < 2; ++bj)
#pragma unroll
                    for (int n = 0; n < 2; ++n) *(f32x4*)(E + ((size_t)row * 16 + u.pn) * 256 + bj * 128 + wc * 32 + 16 * n + 4 * fq) = acc[ai][bj][m][n]; }
    }
};
struct EpiS5Y {
    static constexpr bool PERM = true, AFTER_DRAIN = false; bf16* YA;
    __device__ __forceinline__ void operator()(EPI_ARGS) const {
#pragma unroll
        for (int ai = 0; ai < 2; ++ai)
#pragma unroll
            for (int m = 0; m < 4; ++m) { const int row = u.pm * 256 + ai * 128 + wr * 64 + m * 16 + fr;
#pragma unroll
                for (int bj = 0; bj < 2; ++bj) { const int n0 = bj * 128 + wc * 32 + 8 * fq; f32x4 v0 = acc[ai][bj][m][0], v1 = acc[ai][bj][m][1];
#pragma unroll
                    for (int e = 0; e < 4; ++e) { v0[e] = gelu_tanh(v0[e]); v1[e] = gelu_tanh(v1[e]); }
                    *(u32x4*)(YA + ((size_t)row * 16 + (n0 >> 4)) * 256 + u.pn * 16 + (n0 & 15)) = pack8(v0, v1); } }
    }
};
struct EpiGLU {
    static constexpr bool PERM = true, AFTER_DRAIN = false; const bf16* YA; bf16* Y; const float* gb;
    __device__ __forceinline__ void operator()(EPI_ARGS) const {
#pragma unroll
        for (int bj = 0; bj < 2; ++bj) { const int col = bj * 128 + wc * 32 + 8 * fq; const f32x4 b0 = *(const f32x4*)(gb + col), b1 = *(const f32x4*)(gb + col + 4);
#pragma unroll
            for (int ai = 0; ai < 2; ++ai)
#pragma unroll
                for (int m = 0; m < 4; ++m) { const int row = u.pm * 256 + ai * 128 + wr * 64 + m * 16 + fr; const u32x4 yw = *(const u32x4*)(YA + (size_t)row * 256 + col);
                    f32x4 v0 = acc[ai][bj][m][0] + b0, v1 = acc[ai][bj][m][1] + b1;
                    v0[0] = bflo(yw.x) * sigm(v0[0]); v0[1] = bfhi(yw.x) * sigm(v0[1]); v0[2] = bflo(yw.y) * sigm(v0[2]); v0[3] = bfhi(yw.y) * sigm(v0[3]);
                    v1[0] = bflo(yw.z) * sigm(v1[0]); v1[1] = bfhi(yw.z) * sigm(v1[1]); v1[2] = bflo(yw.w) * sigm(v1[2]); v1[3] = bfhi(yw.w) * sigm(v1[3]);
                    *(u32x4*)(Y + (size_t)row * 1280 + col) = pack8(v0, v1); } }
    }
};
struct EpiRes {
    static constexpr bool PERM = false, AFTER_DRAIN = false; float* Hf;
    __device__ __forceinline__ void operator()(EPI_ARGS) const {
#pragma unroll
        for (int ai = 0; ai < 2; ++ai)
#pragma unroll
            for (int m = 0; m < 4; ++m) { const int row = u.pm * 256 + ai * 128 + wr * 64 + m * 16 + fr;
#pragma unroll
                for (int bj = 0; bj < 2; ++bj)
#pragma unroll
                    for (int n = 0; n < 2; ++n) { float* p = Hf + (size_t)row * D + u.pn * 256 + bj * 128 + wc * 32 + 16 * n + 4 * fq; const f32x4 v = *(const f32x4*)p; *(f32x4*)p = v * DN_ALPHA + acc[ai][bj][m][n]; } }
    }
};
struct EpiSwi {
    static constexpr bool PERM = true, AFTER_DRAIN = false; bf16* ACT;
    __device__ __forceinline__ void operator()(EPI_ARGS) const {
#pragma unroll
        for (int ai = 0; ai < 2; ++ai)
#pragma unroll
            for (int m = 0; m < 4; ++m) { const int row = u.pm * 256 + ai * 128 + wr * 64 + m * 16 + fr; f32x4 v0 = acc[ai][0][m][0], v1 = acc[ai][0][m][1]; const f32x4 g0 = acc[ai][1][m][0], g1 = acc[ai][1][m][1];
#pragma unroll
                for (int e = 0; e < 4; ++e) { v0[e] = v0[e] * sigm(v0[e]) * g0[e]; v1[e] = v1[e] * sigm(v1[e]) * g1[e]; }
                *(u32x4*)(ACT + (size_t)row * DFF + u.pn * 128 + wc * 32 + 8 * fq) = pack8(v0, v1); }
    }
};

__device__ __forceinline__ void tr_item(const float* __restrict__ W, int ldw, int Ksrc, int Nsrc, int k0, int n0, const float* __restrict__ mu, float sa, float sb,
                                        bf16* WT, int ldk, long drow0, int dk0, LAS float* scr, int lane) {
    const int nn = n0 + (lane & 31);
    float tv[32];
#pragma unroll
    for (int i = 0; i < 32; ++i) { const int k = k0 + 2 * i + (lane >> 5); tv[i] = (k < Ksrc && nn < Nsrc) ? W[(size_t)k * ldw + nn] : 0.f; }
    if (mu) {
#pragma unroll
        for (int i = 0; i < 32; ++i) { const int k = k0 + 2 * i + (lane >> 5); if (k < Ksrc) tv[i] *= (sa + sb * mu[k]); } }
#pragma unroll
    for (int i = 0; i < 32; ++i) scr[(2 * i + (lane >> 5)) * 33 + (lane & 31)] = tv[i];
    LDS_FENCE();
    const int c = lane & 7;
#pragma unroll
    for (int j = 0; j < 4; ++j) { const int n = (lane >> 3) + 8 * j; const LAS float* s = scr + (8 * c) * 33 + n;
        u32x4 o; o.x = pk2(s[0 * 33], s[1 * 33]); o.y = pk2(s[2 * 33], s[3 * 33]); o.z = pk2(s[4 * 33], s[5 * 33]); o.w = pk2(s[6 * 33], s[7 * 33]);
        *(u32x4*)(WT + (size_t)(drow0 + n) * ldk + dk0 + 8 * c) = o; }
    LDS_FENCE();
}

__device__ __forceinline__ void prep_weights(const Args& A, GAS unsigned char* ws_, int l, LAS unsigned char* lds, int wave, int lane, int gw, int NGW) {
    GAS unsigned char* wb = ws_ + WS_WB;
    bf16* WIN = (bf16*)(wb + WB_WIN); bf16* WL2 = (bf16*)(wb + WB_WL2); bf16* GLU = (bf16*)(wb + WB_GLU); bf16* WOUT = (bf16*)(wb + WB_WOUT); bf16* W13 = (bf16*)(wb + WB_W13); bf16* W2 = (bf16*)(wb + WB_W2);
    f32x2* LB = (f32x2*)(wb + WB_SC + SC_LB); f32x2* BB = (f32x2*)(wb + WB_SC + SC_BB);
    LAS float* scr = (LAS float*)(lds + wave * 16384);
    LAS float* trig = scr + 2112;
    { float sn, cs; sincospif((float)lane * (1.0f / 32.0f), &sn, &cs); trig[lane] = cs; trig[64 + lane] = sn; }
    LDS_FENCE();
    constexpr int J1 = 16 * 64, J2 = 128, J3 = 128, J4 = 160, J5 = 96, J6 = 320, J7 = 32, J8 = 12 * 32, J9 = 1024, J10 = 2 * 16 * 88, J11 = 44 * 32, J12 = 32;
    constexpr int NIT = J1 + J2 + J3 + J4 + J5 + J6 + J7 + J8 + J9 + J10 + J11 + J12;
    for (int it = gw; it < NIT; it += NGW) {
        int r = it;
        const float* src = nullptr; const float* mu = nullptr; int ldw = 0, Ks = 0, Ns = 0, k0 = 0, n0 = 0, ldk = 1024, dk0 = 0; long drow0 = 0; float sa = 1.f, sb = 0.f; bf16* WT = WIN; int kind = 0;
        if (r < J1) { src = A.in[lnd(I_WIN)] + (size_t)l * 1024 * 2048; ldw = 2048; Ks = 1024; Ns = 2048; k0 = (r >> 6) * 64; n0 = (r & 63) * 32; drow0 = n0; dk0 = k0; }
        else if ((r -= J1) < J2 + J3) { const int isa = r >= J2; if (isa) r -= J2; const int nb = r & 1, kb = (r >> 1) & 15, part = (r >> 5) & 1, d = r >> 6;
            src = A.in[lnd(isa ? I_A1 : I_W1)] + ((size_t)l * 2 + d) * 1024 * 64; mu = A.in[lnd(isa ? I_MUA : I_MUW)] + ((size_t)l * 2 + d) * 1024;
            ldw = 64; Ks = 1024; Ns = 64; k0 = kb * 64; n0 = nb * 32; sa = part ? 0.f : 1.f; sb = part ? 1.f : -1.f; drow0 = 2048 + isa * 256 + d * 128 + part * 64 + nb * 32; dk0 = k0; }
        else if ((r -= J2 + J3) < J4) { const int part = r / 80, q = r % 80, kb = q / 5, nb = q % 5;
            src = A.in[lnd(I_G1)] + (size_t)l * 1024 * 160; mu = A.in[lnd(I_MUG)] + (size_t)l * 1024; ldw = 160; Ks = 1024; Ns = 160; k0 = kb * 64; n0 = nb * 32; sa = part ? 0.f : 1.f; sb = part ? 0.5f : -1.f; drow0 = 2560 + part * 160 + nb * 32; dk0 = k0; }
        else if ((r -= J4) < J5) { drow0 = 2880 + (r / 16) * 32; dk0 = (r % 16) * 64; }
        else if ((r -= J5) < J6) { const int rb = r >> 3, kb = r & 7, row0 = rb * 32; WT = WL2; ldk = 512; drow0 = row0; dk0 = kb * 64; ldw = 256; Ns = 256;
            if (row0 < 512) { const int d = row0 >> 8; if (kb == d) { src = A.in[lnd(I_W2)] + ((size_t)l * 2 + d) * 64 * 256; Ks = 64; n0 = row0 & 255; } }
            else if (row0 < 1024) { const int d = (row0 - 512) >> 8; if (kb == 2 + d) { src = A.in[lnd(I_A2)] + ((size_t)l * 2 + d) * 64 * 256; Ks = 64; n0 = row0 & 255; } }
            else if (kb >= 4 && kb < 7) { src = A.in[lnd(I_G2)] + (size_t)l * 160 * 256; Ks = 160; k0 = (kb - 4) * 64; n0 = row0 - 1024; } }
        else if ((r -= J6) < J7) { src = A.in[lnd(I_GLUW)] + (size_t)l * 65536; ldw = 256; Ks = 256; Ns = 256; k0 = (r >> 3) * 64; n0 = (r & 7) * 32; WT = GLU; ldk = 256; drow0 = n0; dk0 = k0; }
        else if ((r -= J7) < J8) { src = A.in[lnd(I_WOUT)] + (size_t)l * 1024 * 1024; ldw = 1024; Ks = 768; Ns = 1024; k0 = (r >> 5) * 64; n0 = (r & 31) * 32; WT = WOUT; ldk = 1280; drow0 = n0; dk0 = k0; }
        else if ((r -= J8) < J9) kind = 1;
        else if ((r -= J9) < J10) { const int w3 = r >= 1408; if (w3) r -= 1408; const int kb = r / 88, nb = r % 88; n0 = nb * 32; k0 = kb * 64;
            src = A.in[lnd(w3 ? I_FW3 : I_FW1)] + (size_t)l * 1024 * DFF; ldw = DFF; Ks = 1024; Ns = DFF; WT = W13; ldk = 1024; drow0 = (n0 >> 7) * 256 + w3 * 128 + (n0 & 127); dk0 = k0; }
        else if ((r -= J10) < J11) { src = A.in[lnd(I_FW2)] + (size_t)l * DFF * 1024; ldw = 1024; Ks = DFF; Ns = 1024; k0 = (r >> 5) * 64; n0 = (r & 31) * 32; WT = W2; ldk = DFF; drow0 = n0; dk0 = k0; }
        else { r -= J11; kind = 2; }
        if (kind == 0) { tr_item(src, ldw, Ks, Ns, k0, n0, mu, sa, sb, WT, ldk, drow0, dk0, scr, lane); continue; }
        if (kind == 1) { const int c8 = r & 7, nb = (r >> 3) & 31, g = r >> 8; const float* W = A.in[lnd(I_WOUT)] + (size_t)l * 1024 * 1024 + (size_t)(768 + g * 64) * 1024 + nb * 32;
#pragma unroll 4
            for (int i = 0; i < 32; ++i) { const int kk = 2 * i + (lane >> 5); scr[kk * 33 + (lane & 31)] = W[(size_t)kk * 1024 + (lane & 31)]; }
            LDS_FENCE();
            const int n = lane & 31, part = lane >> 5; float o[8];
#pragma unroll
            for (int q = 0; q < 8; ++q) { const int c = c8 * 8 + q; float s = 0.f;
#pragma unroll 4
                for (int cp = 0; cp < 64; ++cp) s += trig[part * 64 + ((c * cp) & 63)] * scr[cp * 33 + n];
                o[q] = s; }
            u32x4 w; w.x = pk2(o[0], o[1]); w.y = pk2(o[2], o[3]); w.z = pk2(o[4], o[5]); w.w = pk2(o[6], o[7]);
            *(u32x4*)(WOUT + (size_t)(nb * 32 + n) * 1280 + 768 + g * 128 + part * 64 + c8 * 8) = w;
            LDS_FENCE(); continue; }
        {
            const int d = r >> 4, g = r & 15, p = lane; const size_t dg = (size_t)(l * 2 + d) * 16 + g;
            const float lre = A.in[lnd(I_LRE)][dg * 64 + p], lim = A.in[lnd(I_LIM)][dg * 64 + p], dt = expf(A.in[lnd(I_LOGDT)][dg]);
            const float mag = expf(lre * dt); float sn, cs; sincospif(lim * dt * 0.3183098861837907f, &sn, &cs);
            const f32x2 lb = {mag * cs, mag * sn}; const float den = lre * lre + lim * lim, nr = lb.x - 1.0f;
            const f32x2 coef = {(nr * lre + lb.y * lim) / den, (lb.y * lre - nr * lim) / den};
            f32x2 pw = {1.f, 0.f};
            for (int k = 0; k < 17; ++k) { LB[((size_t)(d * 16 + g) * 17 + k) * 64 + p] = pw; pw = cmul(pw, lb); }
            const float* bre = A.in[lnd(I_BRE)] + (((size_t)l * 16 + g) * 64 + p) * 16; const float* bim = A.in[lnd(I_BIM)] + (((size_t)l * 16 + g) * 64 + p) * 16;
            for (int h = 0; h < 16; ++h) BB[((size_t)(d * 16 + g) * 64 + p) * 16 + h] = cmul(coef, (f32x2){bre[h], bim[h]});
        }
    }
}
__device__ __forceinline__ void prep_s5_b(const Args& A, GAS unsigned char* ws_, int l, int lane, int gw, int NGW) {
    GAS unsigned char* wb = ws_ + WS_WB; bf16* S5E = (bf16*)(wb + WB_S5E);
    const f32x2* LB = (const f32x2*)(wb + WB_SC + SC_LB); const f32x2* BB = (const f32x2*)(wb + WB_SC + SC_BB); float* KT = (float*)(wb + WB_SC + SC_KT);
    for (int it = gw; it < 4096 + 512; it += NGW) {
        if (it < 4096) { const int g = it >> 8, n = it & 255, d = n >> 7, ri = (n >> 6) & 1, p = n & 63, tp = lane >> 2, h0 = (lane & 3) * 4, ex = d ? tp : 15 - tp;
            const f32x2 lbp = LB[((size_t)(d * 16 + g) * 17 + ex) * 64 + p]; float o[4];
#pragma unroll
            for (int e = 0; e < 4; ++e) { const f32x2 pr = cmul(lbp, BB[((size_t)(d * 16 + g) * 64 + p) * 16 + h0 + e]); o[e] = ri ? pr.y : pr.x; }
            u32x2 w; w.x = pk2(o[0], o[1]); w.y = pk2(o[2], o[3]); *(u32x2*)(S5E + ((size_t)g * 256 + n) * 256 + lane * 4) = w;
        } else { const int r = it - 4096, lag = r & 15, d = (r >> 4) & 1, g = r >> 5, h = lane >> 2, h0 = (lane & 3) * 4;
            const float* cre = A.in[lnd(I_CRE)] + ((((size_t)l * 2 + d) * 16 + g) * 16 + h) * 64; const float* cim = A.in[lnd(I_CIM)] + ((((size_t)l * 2 + d) * 16 + g) * 16 + h) * 64;
            float a0 = 0.f, a1 = 0.f, a2 = 0.f, a3 = 0.f;
            for (int p = 0; p < 64; ++p) { const f32x2 w = cmul((f32x2){cre[p], cim[p]}, LB[((size_t)(d * 16 + g) * 17 + lag) * 64 + p]); const f32x2* bb = BB + ((size_t)(d * 16 + g) * 64 + p) * 16 + h0;
                a0 += w.x * bb[0].x - w.y * bb[0].y; a1 += w.x * bb[1].x - w.y * bb[1].y; a2 += w.x * bb[2].x - w.y * bb[2].y; a3 += w.x * bb[3].x - w.y * bb[3].y; }
            *(f32x4*)(KT + ((((size_t)g * 2 + d) * 16 + lag) * 16 + h) * 16 + h0) = (f32x4){a0, a1, a2, a3}; }
    }
}
__device__ __forceinline__ void prep_s5_c(const Args& A, GAS unsigned char* ws_, int l, int lane, int gw, int NGW) {
    GAS unsigned char* wb = ws_ + WS_WB; bf16* S5Y = (bf16*)(wb + WB_S5Y);
    const f32x2* LB = (const f32x2*)(wb + WB_SC + SC_LB); const float* KT = (const float*)(wb + WB_SC + SC_KT);
    for (int it = gw; it < 4096; it += NGW) { const int g = it >> 8, n = it & 255, t = n >> 4, h = n & 15; float o[8];
        if (lane < 32) { const int tp = lane >> 1, h0 = (lane & 1) * 8;
#pragma unroll
            for (int q = 0; q < 8; ++q) { float v = 0.f;
                if (tp <= t) v += KT[((((size_t)g * 2 + 0) * 16 + (t - tp)) * 16 + h) * 16 + h0 + q];
                if (tp >= t) v += KT[((((size_t)g * 2 + 1) * 16 + (tp - t)) * 16 + h) * 16 + h0 + q];
                if (tp == t && h0 + q == h) v += A.in[lnd(I_S5D)][((size_t)l * 16 + g) * 16 + h];
                o[q] = v; }
        } else { const int kk0 = (lane - 32) * 8, d = kk0 >> 7, ri = (kk0 >> 6) & 1, p0 = kk0 & 63, ex = d ? 16 - t : t + 1;
            const float* cre = A.in[lnd(I_CRE)] + ((((size_t)l * 2 + d) * 16 + g) * 16 + h) * 64 + p0; const float* cim = A.in[lnd(I_CIM)] + ((((size_t)l * 2 + d) * 16 + g) * 16 + h) * 64 + p0;
#pragma unroll
            for (int q = 0; q < 8; ++q) { const f32x2 w = cmul((f32x2){cre[q], cim[q]}, LB[((size_t)(d * 16 + g) * 17 + ex) * 64 + p0 + q]); o[q] = ri ? -w.y : w.x; } }
        u32x4 w; w.x = pk2(o[0], o[1]); w.y = pk2(o[2], o[3]); w.z = pk2(o[4], o[5]); w.w = pk2(o[6], o[7]);
        *(u32x4*)(S5Y + ((size_t)g * 256 + n) * 512 + lane * 8) = w; }
}

__device__ __forceinline__ void ln_row(const float* src, const float* gam, const float* bet, float* dstf, bf16* dstb, int lane) {
    const f32x4* xr = (const f32x4*)src + lane; f32x4 v[4]; float s = 0.f;
#pragma unroll
    for (int j = 0; j < 4; ++j) { v[j] = xr[64 * j]; s += (v[j].x + v[j].y) + (v[j].z + v[j].w); }
    const float mean = wave_sum(s) * (1.f / D); float s2 = 0.f;
#pragma unroll
    for (int j = 0; j < 4; ++j) { v[j] = v[j] - mean; s2 += (v[j].x * v[j].x + v[j].y * v[j].y) + (v[j].z * v[j].z + v[j].w * v[j].w); }
    const float rstd = 1.f / sqrtf(wave_sum(s2) * (1.f / D) + LN_EPS);
#pragma unroll
    for (int j = 0; j < 4; ++j) { const f32x4 g4 = ((const f32x4*)gam)[lane + 64 * j], b4 = ((const f32x4*)bet)[lane + 64 * j]; const f32x4 o = v[j] * rstd * g4 + b4;
        ((f32x4*)dstf)[lane + 64 * j] = o; u32x2 w; w.x = pk2(o.x, o.y); w.y = pk2(o.z, o.w); ((u32x2*)dstb)[lane + 64 * j] = w; }
}
__device__ __forceinline__ void ld8(const bf16* p, float (&o)[8]) { const u32x4 w = *(const u32x4*)p; o[0] = bflo(w.x); o[1] = bfhi(w.x); o[2] = bflo(w.y); o[3] = bfhi(w.y); o[4] = bflo(w.z); o[5] = bfhi(w.z); o[6] = bflo(w.w); o[7] = bfhi(w.w); }
__device__ __forceinline__ void lora_act_row(const bf16* PL, bf16* LA, int m, int lane) {
    const int s = m & (SEQ - 1); const bool hp = s > 0, hn = s < SEQ - 1; float o[8];
#pragma unroll
    for (int q = 0; q < 8; ++q) o[q] = 0.f;
    const bf16* row = PL + (size_t)m * 1024;
    if (lane < 32) { const int blk = lane >> 3, c = (lane & 7) * 8, d = blk & 1; float a[8], b[8];
        ld8(row + (blk >> 1) * 256 + d * 128 + c, a);
        const bool ok = d ? hn : hp;
        if (ok) { ld8(row + (d ? 1024 : -1024) + (blk >> 1) * 256 + d * 128 + 64 + c, b);
#pragma unroll
            for (int q = 0; q < 8; ++q) a[q] += b[q]; }
#pragma unroll
        for (int q = 0; q < 8; ++q) o[q] = (blk < 2) ? tanh_(a[q]) : a[q];
    } else if (lane < 52) { const int r = (lane - 32) * 8; float a[8], b[8]; ld8(row + 512 + r, a);
        if (hp) { ld8(row - 1024 + 672 + r, b);
#pragma unroll
            for (int q = 0; q < 8; ++q) a[q] += b[q]; }
        if (hn) { ld8(row + 1024 + 672 + r, b);
#pragma unroll
            for (int q = 0; q < 8; ++q) a[q] += b[q]; }
#pragma unroll
        for (int q = 0; q < 8; ++q) o[q] = sigm(a[q]); }
    u32x4 w; w.x = pk2(o[0], o[1]); w.y = pk2(o[2], o[3]); w.z = pk2(o[4], o[5]); w.w = pk2(o[6], o[7]);
    *(u32x4*)(LA + (size_t)m * 512 + lane * 8) = w;
}
__device__ __forceinline__ void ld4(const bf16* p, float (&o)[4]) { const u32x2 w = *(const u32x2*)p; o[0] = bflo(w.x); o[1] = bfhi(w.x); o[2] = bflo(w.y); o[3] = bfhi(w.y); }
__device__ __forceinline__ void conv_row(const bf16* PC, const float* cw, bf16* Y, int m, int lane) {
    const int s = m & (SEQ - 1), c = lane * 4; const bf16* row = PC + (size_t)m * 768 + c; float bg[4], cg[4], xc[4], z[4], acc[4];
    ld4(row, bg); ld4(row + 256, cg); ld4(row + 512, xc);
    const f32x4 w0 = *(const f32x4*)(cw + c), w1 = *(const f32x4*)(cw + 256 + c), w2 = *(const f32x4*)(cw + 512 + c);
#pragma unroll
    for (int q = 0; q < 4; ++q) acc[q] = w1[q] * (cg[q] * xc[q]);
    if (s > 0) { ld4(row - 768 + 256, cg); ld4(row - 768 + 512, xc);
#pragma unroll
        for (int q = 0; q < 4; ++q) acc[q] += w0[q] * (cg[q] * xc[q]); }
    if (s < SEQ - 1) { ld4(row + 768 + 256, cg); ld4(row + 768 + 512, xc);
#pragma unroll
        for (int q = 0; q < 4; ++q) acc[q] += w2[q] * (cg[q] * xc[q]); }
    (void)z; u32x2 w; w.x = pk2(bg[0] * acc[0], bg[1] * acc[1]); w.y = pk2(bg[2] * acc[2], bg[3] * acc[3]);
    *(u32x2*)(Y + (size_t)m * 1280 + 512 + c) = w;
}

template <int N, int NC>
__device__ __forceinline__ LAS f32x2* fft_lds(LAS f32x2* Abuf, LAS f32x2* Bbuf, const LAS f32x2* tw, int tid) {
    LAS f32x2* X = Abuf; LAS f32x2* Yb = Bbuf;
    for (int p = 1; p < N; p <<= 1) {
        for (int idx = tid; idx < (N / 2) * NC; idx += NTHR) { const int col = idx % NC, i = idx / NC, k = i & (p - 1), j = ((i - k) << 1) + k;
            const f32x2 w = tw[k * (N / 2 / p)], u0 = X[i * NC + col], u1 = cmul(X[(i + N / 2) * NC + col], w);
            Yb[j * NC + col] = u0 + u1; Yb[(j + p) * NC + col] = u0 - u1; }
        __syncthreads();
        LAS f32x2* t = X; X = Yb; Yb = t;
    }
    return X;
}
__device__ __forceinline__ void fft_step1(const bf16* PF, f32x2* FM, LAS unsigned char* lds, int tid, int bid, int G) {
    LAS f32x2* Ab = (LAS f32x2*)lds; LAS f32x2* Bb = (LAS f32x2*)(lds + 65536); LAS f32x2* tw = (LAS f32x2*)(lds + 131072);
    if (tid < 64) { float sn, cs; sincospif((float)tid * (1.0f / 64.0f), &sn, &cs); tw[tid] = (f32x2){cs, -sn}; }
    __syncthreads();
    for (int un = bid; un < 512; un += G) { const int cgp = un & 3, s2 = (un >> 2) & 63, b = un >> 8;
        for (int idx = tid; idx < 1024; idx += NTHR) { const int s1 = idx >> 3, c8 = (idx & 7) * 8; float v[8]; ld8(PF + (size_t)(b * SEQ + 64 * s1 + s2) * 256 + cgp * 64 + c8, v);
#pragma unroll
            for (int q = 0; q < 8; ++q) Ab[s1 * 64 + c8 + q] = (f32x2){v[q], 0.f}; }
        __syncthreads();
        LAS f32x2* R = fft_lds<128, 64>(Ab, Bb, tw, tid);
        for (int idx = tid; idx < 128 * 64; idx += NTHR) { const int k1 = idx >> 6, col = idx & 63; FM[((size_t)(b * 128 + k1) * 64 + s2) * 256 + cgp * 64 + col] = R[idx]; }
        __syncthreads();
    }
}
__device__ __forceinline__ void fft_step3(const f32x2* FM, bf16* Y, LAS unsigned char* lds, int tid, int bid, int G) {
    LAS f32x2* Ab = (LAS f32x2*)lds; LAS f32x2* Bb = (LAS f32x2*)(lds + 65536); LAS f32x2* tw = (LAS f32x2*)(lds + 131072); LAS f32x2* tw2 = tw + 32;
    if (tid < 32) { float sn, cs; sincospif((float)tid * (1.0f / 32.0f), &sn, &cs); tw[tid] = (f32x2){cs, -sn}; }
    __syncthreads();
    for (int un = bid; un < 512; un += G) { const int half = un & 1, k1 = (un >> 1) & 127, b = un >> 8;
        if (tid < 64) { float sn, cs; sincospif((float)((k1 * tid) & 8191) * (1.0f / 4096.0f), &sn, &cs); tw2[tid] = (f32x2){cs, -sn}; }
        __syncthreads();
        for (int idx = tid; idx < 64 * 128; idx += NTHR) { const int s2 = idx >> 7, col = idx & 127; Ab[idx] = cmul(FM[((size_t)(b * 128 + k1) * 64 + s2) * 256 + half * 128 + col], tw2[s2]); }
        __syncthreads();
        LAS f32x2* R = fft_lds<64, 128>(Ab, Bb, tw, tid);
        for (int idx = tid; idx < 64 * 128; idx += NTHR) { const int k2 = idx >> 7, col = idx & 127, cg2 = half * 128 + col, grp = cg2 >> 6, c = cg2 & 63; const f32x2 v = R[idx];
            bf16* yp = Y + (size_t)(b * SEQ + k1 + 128 * k2) * 1280 + 768 + grp * 128 + c; yp[0] = (bf16)f2bf(v.x * FFT_SCALE); yp[64] = (bf16)f2bf(v.y * FFT_SCALE); }
        __syncthreads();
    }
}

__device__ __forceinline__ void s5_carry(const float* E, bf16* X2, const f32x2* LB, LAS unsigned char* lds, int j, int tid) {
    const int b = j >> 5, g = (j >> 1) & 15, d = j & 1, seg = tid >> 6, p = tid & 63;
    LAS f32x2* es = (LAS f32x2*)lds;
    const f32x2 A16 = LB[((size_t)(d * 16 + g) * 17 + 16) * 64 + p];
    const int c0 = d ? seg * 64 + 63 : seg * 64, cs = d ? -1 : 1;
    const float* Eb = E + ((size_t)(b * 512) * 16 + g) * 256 + d * 128 + p;
    f32x2 x = {0.f, 0.f};
#pragma unroll 8
    for (int i = 0; i < 64; ++i) { const int c = c0 + cs * i; const float* e = Eb + (size_t)c * 4096; x = cmul(A16, x) + (f32x2){e[0], e[64]}; }
    es[seg * 64 + p] = x;
    f32x2 A64 = A16;
#pragma unroll
    for (int q = 0; q < 6; ++q) A64 = cmul(A64, A64);
    __syncthreads();
    x = (f32x2){0.f, 0.f};
    if (d == 0) { for (int s = 0; s < seg; ++s) x = cmul(A64, x) + es[s * 64 + p]; } else { for (int s = 7; s > seg; --s) x = cmul(A64, x) + es[s * 64 + p]; }
    const int nre = d * 128 + p, nim = nre + 64;
#pragma unroll 8
    for (int i = 0; i < 64; ++i) { const int c = c0 + cs * i, cc = b * 512 + c; const float* e = Eb + (size_t)c * 4096;
        X2[((size_t)cc * 16 + (nre >> 4)) * 256 + g * 16 + (nre & 15)] = (bf16)f2bf(x.x); X2[((size_t)cc * 16 + (nim >> 4)) * 256 + g * 16 + (nim & 15)] = (bf16)f2bf(x.y);
        x = cmul(A16, x) + (f32x2){e[0], e[64]}; }
    __syncthreads();
}

__device__ __forceinline__ float row_sum16(float x) {
    x += __builtin_bit_cast(float, __builtin_amdgcn_update_dpp(0, __builtin_bit_cast(int, x), 0xB1, 0xF, 0xF, true));
    x += __builtin_bit_cast(float, __builtin_amdgcn_update_dpp(0, __builtin_bit_cast(int, x), 0x4E, 0xF, 0xF, true));
    x += __builtin_bit_cast(float, __builtin_amdgcn_update_dpp(0, __builtin_bit_cast(int, x), 0x141, 0xF, 0xF, true));
    x += __builtin_bit_cast(float, __builtin_amdgcn_update_dpp(0, __builtin_bit_cast(int, x), 0x140, 0xF, 0xF, true));
    return x;
}
__device__ __forceinline__ f32x4 ld4v(const bf16* p) { const u32x2 w = *(const u32x2*)p; return (f32x4){bflo(w.x), bfhi(w.x), bflo(w.y), bfhi(w.y)}; }
struct RwkvCtx { const bf16* Prkv; const bf16* DA; const float* mu; const float* kkp; const float* kap; const float* rkp; int d, b, h; };
__device__ __forceinline__ RwkvCtx rwkv_ctx(const Args& A, GAS unsigned char* ws_, int l, int d, int b, int h, int q) {
    RwkvCtx c; c.Prkv = (const bf16*)(ws_ + WS_PRKV); c.DA = (const bf16*)(ws_ + WS_DA); c.d = d; c.b = b; c.h = h;
    c.mu = A.in[lnd(I_MURKV)] + ((size_t)l * 2 + d) * 768 + h * 64; c.kkp = A.in[lnd(I_KK)] + (size_t)l * 256 + h * 64; c.kap = A.in[lnd(I_KA)] + (size_t)l * 256 + h * 64; c.rkp = A.in[lnd(I_RK)] + (size_t)l * 256 + h * 64;
    return c;
}
__device__ __forceinline__ void rwkv_ops4(const RwkvCtx& c, int tau, int q, f32x4& r, f32x4& k2, f32x4& v, f32x4& kk, f32x4& a, f32x4& dec) {
    const int s = c.d ? SEQ - 1 - tau : tau; const size_t m = (size_t)c.b * SEQ + s;
    const bf16* p = c.Prkv + m * 768 + c.h * 64 + 4 * q; const f32x4 pr = ld4v(p), pk = ld4v(p + 256), pv = ld4v(p + 512);
    f32x4 ppr = {0.f, 0.f, 0.f, 0.f}, ppk = ppr, ppv = ppr;
    if (tau > 0) { const bf16* pp = c.d ? p + 768 : p - 768; ppr = ld4v(pp); ppk = ld4v(pp + 256); ppv = ld4v(pp + 512); }
    const bf16* qd = c.DA + m * 1024 + c.d * 256 + c.h * 64 + 4 * q; dec = ld4v(qd); a = ld4v(qd + 512);
    const f32x4 mur = *(const f32x4*)(c.mu + 4 * q), muk = *(const f32x4*)(c.mu + 256 + 4 * q), muv = *(const f32x4*)(c.mu + 512 + 4 * q), kkw = *(const f32x4*)(c.kkp + 4 * q), kaw = *(const f32x4*)(c.kap + 4 * q);
    r = pr + (ppr - pr) * mur; const f32x4 k = pk + (ppk - pk) * muk; v = pv + (ppv - pv) * muv;
    kk = k * kkw; const float nrm = row_sum16((kk.x * kk.x + kk.y * kk.y) + (kk.z * kk.z + kk.w * kk.w)); kk = kk * rsqrtf(nrm + 1e-12f);
    k2 = k * ((a - 1.0f) * kaw + 1.0f);
}
__device__ __forceinline__ void rwkv_prep8(const RwkvCtx& c, int tau0, LAS float* ob, int lane) {
    int lp = lane; asm volatile("" : "+v"(lp)); const int sq = lp >> 4, q = lp & 15;
#pragma unroll 1
    for (int it = 0; it < 2; ++it) { f32x4 r, k2, v, kk, a, dec; rwkv_ops4(c, tau0 + it * 4 + sq, q, r, k2, v, kk, a, dec);
        LAS float* o = ob + (it * 4 + sq) * 384 + 4 * q;
        *(LAS f32x4*)o = dec; *(LAS f32x4*)(o + 64) = -kk; *(LAS f32x4*)(o + 128) = kk * a; *(LAS f32x4*)(o + 192) = k2; *(LAS f32x4*)(o + 256) = r; *(LAS f32x4*)(o + 320) = v; }
}
#define SCHED_BAR() __builtin_amdgcn_sched_barrier(0)
__device__ __forceinline__ void rwkv_phase1(const Args& A, GAS unsigned char* ws_, int l, LAS unsigned char* lds, int wave, int lane, int bid, int G) {
    float* PQP = (float*)(ws_ + WS_PQP); float* PQQ = (float*)(ws_ + WS_PQQ); bf16* Zb = (bf16*)(ws_ + WS_Z); bf16* Qb = (bf16*)(ws_ + WS_QR);
    LAS float* ob = (LAS float*)(lds + wave * 12288);
    for (int unit = bid * 8 + wave; unit < 2048; unit += G * 8) {
        const int chain = unit >> 7, c = unit & 127, d = chain >> 3, b = (chain >> 2) & 1, h = chain & 3;
        const RwkvCtx cx = rwkv_ctx(A, ws_, l, d, b, h, lane & 15);
        float P[64], Q[64];
#pragma unroll
        for (int j = 0; j < 64; ++j) { P[j] = (j == lane) ? 1.f : 0.f; Q[j] = 0.f; }
        for (int blk = 0; blk < 8; ++blk) {
            rwkv_prep8(cx, c * 64 + blk * 8, ob, lane);
            LDS_FENCE();
#pragma unroll 1
            for (int st = 0; st < 8; ++st) { const LAS float* o = ob + st * 384; int lv = lane; asm volatile("" : "+v"(lv)); const float vi = o[320 + lv];
                float sp0 = 0.f, sp1 = 0.f, sq0 = 0.f, sq1 = 0.f;
#pragma unroll
                for (int hb = 0; hb < 2; ++hb) { f32x4 t[8];
#pragma unroll
                    for (int i = 0; i < 8; ++i) t[i] = *(const LAS f32x4*)(o + 64 + hb * 32 + 4 * i);
                    SCHED_BAR();
#pragma unroll
                    for (int i = 0; i < 8; ++i) { const int j = hb * 32 + 4 * i;
                        sp0 += P[j] * t[i].x; sp1 += P[j + 1] * t[i].y; sp0 += P[j + 2] * t[i].z; sp1 += P[j + 3] * t[i].w;
                        sq0 += Q[j] * t[i].x; sq1 += Q[j + 1] * t[i].y; sq0 += Q[j + 2] * t[i].z; sq1 += Q[j + 3] * t[i].w; }
                    SCHED_BAR(); }
                const float saP = sp0 + sp1, saQ = sq0 + sq1;
#pragma unroll
                for (int qb = 0; qb < 8; ++qb) { f32x4 w[2], kb[2], kv[2];
#pragma unroll
                    for (int i = 0; i < 2; ++i) { w[i] = *(const LAS f32x4*)(o + qb * 8 + 4 * i); kb[i] = *(const LAS f32x4*)(o + 128 + qb * 8 + 4 * i); kv[i] = *(const LAS f32x4*)(o + 192 + qb * 8 + 4 * i); }
                    SCHED_BAR();
#pragma unroll
                    for (int i = 0; i < 2; ++i)
#pragma unroll
                        for (int e = 0; e < 4; ++e) { const int j = qb * 8 + 4 * i + e; P[j] = P[j] * w[i][e] + saP * kb[i][e]; Q[j] = Q[j] * w[i][e] + (saQ * kb[i][e] + vi * kv[i][e]); }
                    SCHED_BAR(); }
                float z0 = 0.f, z1 = 0.f, q0 = 0.f, q1 = 0.f;
#pragma unroll
                for (int hb = 0; hb < 2; ++hb) { f32x4 t[8];
#pragma unroll
                    for (int i = 0; i < 8; ++i) t[i] = *(const LAS f32x4*)(o + 256 + hb * 32 + 4 * i);
                    SCHED_BAR();
#pragma unroll
                    for (int i = 0; i < 8; ++i) { const int j = hb * 32 + 4 * i;
                        z0 += P[j] * t[i].x; z1 += P[j + 1] * t[i].y; z0 += P[j + 2] * t[i].z; z1 += P[j + 3] * t[i].w;
                        q0 += Q[j] * t[i].x; q1 += Q[j + 1] * t[i].y; q0 += Q[j + 2] * t[i].z; q1 += Q[j + 3] * t[i].w; }
                    SCHED_BAR(); }
                int ls = lane; asm volatile("" : "+v"(ls));
                const size_t zi = ((size_t)unit * 64 + blk * 8 + st) * 64 + ls; Zb[zi] = (bf16)f2bf(z0 + z1); Qb[zi] = (bf16)f2bf(q0 + q1);
            }
            LDS_FENCE();
        }
        int lf = lane; asm volatile("" : "+v"(lf));
        float* pp = PQP + (size_t)unit * 4096 + lf * 64; float* qq = PQQ + (size_t)unit * 4096 + lf * 64;
#pragma unroll
        for (int jj = 0; jj < 16; ++jj) { *(f32x4*)(pp + 4 * jj) = (f32x4){P[4 * jj], P[4 * jj + 1], P[4 * jj + 2], P[4 * jj + 3]}; *(f32x4*)(qq + 4 * jj) = (f32x4){Q[4 * jj], Q[4 * jj + 1], Q[4 * jj + 2], Q[4 * jj + 3]}; }
    }
}
__device__ __forceinline__ void rwkv_carry(const Args& A, GAS unsigned char* ws_, LAS unsigned char* lds, int tid, int wave, int lane, int j) {
    const float* PQP = (const float*)(ws_ + WS_PQP); float* PQQ = (float*)(ws_ + WS_PQQ);
    const int chain = j >> 2, rg = j & 3; LAS float* Sl = (LAS float*)lds;
    for (int i = tid; i < 16 * 68; i += NTHR) Sl[i] = 0.f;
    __syncthreads();
    const int li = lane & 15, lq = lane >> 4, nt = wave;
    float bN[16]; f32x4 qN = {0.f, 0.f, 0.f, 0.f};
    if (wave < 4) { const float* Pc = PQP + (size_t)(chain * 128) * 4096; const float* Qc = PQQ + (size_t)(chain * 128) * 4096;
#pragma unroll
        for (int kk = 0; kk < 16; ++kk) bN[kk] = Pc[(4 * kk + lq) * 64 + 16 * nt + li];
#pragma unroll
        for (int e = 0; e < 4; ++e) qN[e] = Qc[(rg * 16 + 4 * lq + e) * 64 + 16 * nt + li]; }
    for (int c = 0; c < 127; ++c) {
        f32x4 acc = qN; float bC[16];
        if (wave < 4) {
#pragma unroll
            for (int kk = 0; kk < 16; ++kk) bC[kk] = bN[kk];
            if (c + 1 < 127) { const float* Pc = PQP + (size_t)(chain * 128 + c + 1) * 4096; const float* Qc = PQQ + (size_t)(chain * 128 + c + 1) * 4096;
#pragma unroll
                for (int kk = 0; kk < 16; ++kk) bN[kk] = Pc[(4 * kk + lq) * 64 + 16 * nt + li];
#pragma unroll
                for (int e = 0; e < 4; ++e) qN[e] = Qc[(rg * 16 + 4 * lq + e) * 64 + 16 * nt + li]; }
#pragma unroll
            for (int kk = 0; kk < 16; ++kk) acc = __builtin_amdgcn_mfma_f32_16x16x4f32(Sl[li * 68 + 4 * kk + lq], bC[kk], acc, 0, 0, 0);
            float* Qo = PQQ + (size_t)(chain * 128 + c) * 4096;
#pragma unroll
            for (int e = 0; e < 4; ++e) Qo[(rg * 16 + 4 * lq + e) * 64 + 16 * nt + li] = acc[e];
        }
        __syncthreads();
        if (wave < 4) {
#pragma unroll
            for (int e = 0; e < 4; ++e) Sl[(4 * lq + e) * 68 + 16 * nt + li] = acc[e]; }
        __syncthreads();
    }
}
__device__ __forceinline__ void rwkv_phase3(const Args& A, GAS unsigned char* ws_, int l, LAS unsigned char* lds, int wave, int lane, int bid, int G) {
    const float* PQQ = (const float*)(ws_ + WS_PQQ); float* YS = (float*)(ws_ + WS_YSC); const bf16* Zb = (const bf16*)(ws_ + WS_Z); const bf16* Qb = (const bf16*)(ws_ + WS_QR);
    const int li = lane & 15, lq = lane >> 4;
    for (int unit = bid * 8 + wave; unit < 2048; unit += G * 8) {
        const int chain = unit >> 7, c = unit & 127, d = chain >> 3, b = (chain >> 2) & 1, h = chain & 3;
        f32x4 acc[4][4];
#pragma unroll
        for (int vt = 0; vt < 4; ++vt)
#pragma unroll
            for (int tt = 0; tt < 4; ++tt) acc[vt][tt] = (f32x4){0.f, 0.f, 0.f, 0.f};
        if (c > 0) { const float* Ss = PQQ + (size_t)(unit - 1) * 4096; float av[4][16];
#pragma unroll
            for (int vt = 0; vt < 4; ++vt)
#pragma unroll
                for (int kk = 0; kk < 16; ++kk) av[vt][kk] = Ss[(16 * vt + li) * 64 + 4 * kk + lq];
#pragma unroll
            for (int tt = 0; tt < 4; ++tt) { float bv[16]; const bf16* zp = Zb + ((size_t)unit * 64 + 16 * tt + li) * 64 + lq;
#pragma unroll
                for (int kk = 0; kk < 16; ++kk) bv[kk] = bf2f(zp[4 * kk]);
#pragma unroll
                for (int kk = 0; kk < 16; ++kk)
#pragma unroll
                    for (int vt = 0; vt < 4; ++vt) acc[vt][tt] = __builtin_amdgcn_mfma_f32_16x16x4f32(av[vt][kk], bv[kk], acc[vt][tt], 0, 0, 0); } }
#pragma unroll
        for (int tt = 0; tt < 4; ++tt) { const int t = 16 * tt + li, tau = c * 64 + t, s = d ? SEQ - 1 - tau : tau;
#pragma unroll
            for (int vt = 0; vt < 4; ++vt) { const int v0 = 16 * vt + 4 * lq; const f32x4 qv = ld4v(Qb + ((size_t)unit * 64 + t) * 64 + v0);
                *(f32x4*)(YS + ((size_t)d * T + (size_t)b * SEQ + s) * 256 + h * 64 + v0) = acc[vt][tt] + qv; } }
    }
}
__device__ __forceinline__ void rwkv_post(const Args& A, GAS unsigned char* ws_, int l, int lane, int gw, int NGW) {
    const float* YS = (const float*)(ws_ + WS_YSC); bf16* Y = (bf16*)(ws_ + WS_Y);
    const int h = lane >> 4, q = lane & 15, hj = h * 64 + 4 * q;
    const f32x4 gng = *(const f32x4*)(A.in[lnd(I_GNG)] + (size_t)l * 256 + hj), gnb = *(const f32x4*)(A.in[lnd(I_GNB)] + (size_t)l * 256 + hj);
    for (int m = gw; m < T; m += NGW) { const int b = m >> 13, s = m & (SEQ - 1);
        const f32x4 y = *(const f32x4*)(YS + (size_t)m * 256 + hj) + *(const f32x4*)(YS + ((size_t)T + m) * 256 + hj);
        const float mu = row_sum16((y.x + y.y) + (y.z + y.w)) * (1.f / 64.f); const f32x4 dy = y - mu;
        const float var = row_sum16((dy.x * dy.x + dy.y * dy.y) + (dy.z * dy.z + dy.w * dy.w)) * (1.f / 64.f);
        f32x4 o = dy * rsqrtf(var + GN_EPS) * gng + gnb;
#pragma unroll
        for (int d = 0; d < 2; ++d) { const RwkvCtx cx = rwkv_ctx(A, ws_, l, d, b, h, q); f32x4 r, k2, v, kk, a, dec; rwkv_ops4(cx, d ? SEQ - 1 - s : s, q, r, k2, v, kk, a, dec);
            const f32x4 t = r * k2 * *(const f32x4*)(cx.rkp + 4 * q); o += v * row_sum16((t.x + t.y) + (t.z + t.w)); }
        bf16* yp = Y + (size_t)m * 1280 + 256 + hj; const f32x4 g = ld4v(yp); o = o * g;
        u32x2 w; w.x = pk2(o.x, o.y); w.y = pk2(o.z, o.w); *(u32x2*)yp = w; }
}

#define XB_TMO      128
#define XB_XCNT(j)  (256  + 64 * (j))
#define XB_XSUB(j)  (1280 + 64 * (j))
#define XB_XGEN(j)  (2304 + 64 * (j))
#define XB_TOP      3328
#define XB_TOPGEN   3392
#define XCD_BAR_WORDS 3456
#define XB_SPIN_CAP (1u << 18)

__device__ __forceinline__ unsigned xb_ld(unsigned* p)              { return __hip_atomic_load(p, __ATOMIC_RELAXED, __HIP_MEMORY_SCOPE_AGENT); }
__device__ __forceinline__ unsigned xb_add(unsigned* p, unsigned v) { return __hip_atomic_fetch_add(p, v, __ATOMIC_RELAXED, __HIP_MEMORY_SCOPE_AGENT); }
__device__ __forceinline__ unsigned xb_xcc_id() { return (unsigned)__builtin_amdgcn_s_getreg((3 << 11) | 20) & 0xFu; }
#define XB_SPIN(cond, bar) do { unsigned _sp = 0; while (cond) { __builtin_amdgcn_s_sleep(1); \
    if ((++_sp & 255u) == 0u) { if (xb_ld(&(bar)[XB_TMO])) break; if (_sp > XB_SPIN_CAP) { atomicAdd(&(bar)[XB_TMO], 1u); break; } } } } while (0)

struct XcdBarrier {
    unsigned* bar; unsigned x;
    volatile LAS unsigned* st;
};

__device__ __forceinline__ XcdBarrier xcd_barrier_post(unsigned* bar, volatile LAS unsigned* st, bool leader) {
    XcdBarrier b; b.bar = bar; b.x = xb_xcc_id(); b.st = st;
    if (leader) (void)xb_add(&bar[XB_XCNT(b.x)], 1u);
    return b;
}
__device__ __forceinline__ void xcd_barrier_complete(unsigned* bar, unsigned x, unsigned& nloc, unsigned& nx) {
    const unsigned G = gridDim.x * gridDim.y * gridDim.z;
    unsigned sum, cnt, mine, sp = 0u;
    for (;;) {
        sum = 0u; cnt = 0u; mine = 0u;
#pragma unroll
        for (unsigned j = 0; j < 16; ++j) { const unsigned c = xb_ld(&bar[XB_XCNT(j)]); sum += c; cnt += (c > 0u) ? 1u : 0u; mine = (j == x) ? c : mine; }
        if (sum == G) break;
        __builtin_amdgcn_s_sleep(1);
        if ((++sp & 255u) == 0u) { if (xb_ld(&bar[XB_TMO])) break; if (sp > XB_SPIN_CAP) { atomicAdd(&bar[XB_TMO], 1u); break; } }
    }
    nloc = mine > 0u ? mine : 1u; nx = cnt > 0u ? cnt : 1u;
}

__device__ __forceinline__ void xcd_barrier(const XcdBarrier& b, bool leader) {
    asm volatile("s_waitcnt vmcnt(0)" ::: "memory");
    __syncthreads();
    if (leader) {
        unsigned* bar = b.bar;
        __builtin_amdgcn_s_waitcnt(0);
        unsigned nloc = b.st[0], nx = b.st[1];
        if (nloc == 0u) { xcd_barrier_complete(bar, b.x, nloc, nx); b.st[0] = nloc; b.st[1] = nx; }
        const unsigned old = xb_add(&bar[XB_XSUB(b.x)], 1u);
        const unsigned gen = old / nloc;
        if (old + 1u == (gen + 1u) * nloc) {
            __builtin_amdgcn_fence(__ATOMIC_RELEASE, "agent");
            asm volatile("s_waitcnt vmcnt(0)" ::: "memory");
            const unsigned og = xb_add(&bar[XB_TOP], 1u);
            const unsigned tg = og / nx;
            if (og + 1u == (tg + 1u) * nx) xb_add(&bar[XB_TOPGEN], 1u);
            else XB_SPIN(xb_ld(&bar[XB_TOPGEN]) == tg, bar);
            __builtin_amdgcn_fence(__ATOMIC_ACQUIRE, "agent");
            xb_add(&bar[XB_XGEN(b.x)], 1u);
            asm volatile("s_waitcnt vmcnt(0)" ::: "memory");
        } else {
            XB_SPIN(xb_ld(&bar[XB_XGEN(b.x)]) == gen, bar);
            __builtin_amdgcn_fence(__ATOMIC_ACQUIRE, "agent");
            asm volatile("s_waitcnt vmcnt(0)" ::: "memory");
        }
    }
    __syncthreads();
}

constexpr int PH_PER_LAYER = 12, N_PHASES = 1 + PH_PER_LAYER * NL;
#define Hf (A.out)
#define WSP(type, off) ((type*)(ws_ + (off)))
#define Hb WSP(bf16, WS_HB)
#define Pu WSP(bf16, WS_PU)
#define Prkv WSP(bf16, WS_PRKV)
#define Pconv WSP(bf16, WS_PCONV)
#define Pfft WSP(bf16, WS_PFFT)
#define PL WSP(bf16, WS_PL)
#define LA WSP(bf16, WS_LA)
#define DA WSP(bf16, WS_DA)
#define Y WSP(bf16, WS_Y)
#define YA WSP(bf16, WS_YA)
#define X2 WSP(bf16, WS_X)
#define ACT WSP(bf16, WS_ACT)
#define E WSP(float, WS_E)
#define FM WSP(f32x2, WS_FM)
#define WIN WSP(const bf16, WS_WB + WB_WIN)
#define WL2 WSP(const bf16, WS_WB + WB_WL2)
#define S5E WSP(const bf16, WS_WB + WB_S5E)
#define S5Y WSP(const bf16, WS_WB + WB_S5Y)
#define GLU WSP(const bf16, WS_WB + WB_GLU)
#define WOUT WSP(const bf16, WS_WB + WB_WOUT)
#define W13 WSP(const bf16, WS_WB + WB_W13)
#define W2 WSP(const bf16, WS_WB + WB_W2)
#define LB WSP(const f32x2, WS_WB + WB_SC + SC_LB)
#define IN(k) (lo <= (k) && (k) < hi)
#ifndef PROBE_MASK
#define PROBE_MASK 0u
#endif
#define PROBE_K 4
#define PROBE_SLOT(i) (((LAS unsigned long long*)(lds + 143360))[i])
#define PROBE_MARK(bit) do { if (PROBE_MASK != 0u && blockIdx.x == 0 && wave0 == 0 && __builtin_amdgcn_mbcnt_hi(~0u, __builtin_amdgcn_mbcnt_lo(~0u, 0u)) == 0) { const unsigned long long now_ = __builtin_amdgcn_s_memrealtime(); \
    if ((PROBE_MASK >> (bit)) & 1u) PROBE_SLOT(1) += now_ - PROBE_SLOT(0); PROBE_SLOT(0) = now_; } } while (0)
constexpr int CTL_BAR_BYTE = 16384, LDS_BAR_OFF = 143424;
#define SEAM(k) do { if (IN(k) && IN((k) + 1)) { if ((k) == 0) grid.sync(); else { XcdBarrier xb_; xb_.bar = (unsigned*)(A.ws + CTL_BAR_BYTE); xb_.x = xb_xcc_id(); xb_.st = (volatile LAS unsigned*)(lds + LDS_BAR_OFF); \
    xcd_barrier(xb_, wave0 == 0 && __builtin_amdgcn_mbcnt_hi(~0u, __builtin_amdgcn_mbcnt_lo(~0u, 0u)) == 0); } } PROBE_MARK((k) == 0 ? 12 : ((k) - 1) % PH_PER_LAYER); } while (0)
#define PH_TID() int wave = wave0, bid = blockIdx.x, G = gridDim.x; GAS unsigned char* ws_ = (GAS unsigned char*)A.ws; asm volatile("" : "+s"(wave), "+s"(bid), "+s"(G), "+s"(ws_)); int lane = __builtin_amdgcn_mbcnt_hi(~0u, __builtin_amdgcn_mbcnt_lo(~0u, 0u)); asm volatile("" : "+v"(lane)); const int tid = wave * 64 + lane, gw = bid * 8 + wave, NGW = G * 8; (void)tid; (void)gw; (void)NGW
template <int l>
__device__ __forceinline__ void layer_body(const Args& A, LAS unsigned char* lds, cg::grid_group& grid, const int wave0, const int lo, const int hi) {
    constexpr int p0 = 1 + PH_PER_LAYER * l;
        if (IN(p0 + 0)) { PH_TID();
            pg8::StaticOrder S; S.init(T, 3072, G, bid); EpiP Ep{Pu, Prkv, Pconv, Pfft, PL};
            pg8::gemm_phase<EpiP, pg8::StaticOrder, true, true>(lds, pg8::mk_gemm(Hb, WIN, T, 3072, 1024), S, Ep, wave);
            prep_s5_b(A, ws_, l, lane, gw, NGW);
        }
        SEAM(p0 + 0);
        if (IN(p0 + 1)) { PH_TID();
            for (int m = gw; m < T; m += NGW) { lora_act_row(PL, LA, m, lane); conv_row(Pconv, A.in[lnd(I_CONVW)] + (size_t)l * 768, Y, m, lane); }
            prep_s5_c(A, ws_, l, lane, gw, NGW);
            __syncthreads();
            fft_step1(Pfft, FM, lds, tid, bid, G);
            {
                pg8::Gemm g = pg8::mk_gemm(Pu, S5E, 1024, 4096, 256); g.a_rs = 8192; g.a_k16 = 512; g.a_kstep = 2048; g.a_pn = 32;
                pg8::StaticOrder S; S.init(1024, 4096, G, bid); EpiE Ee{E};
                pg8::gemm_phase<EpiE, pg8::StaticOrder, false, true, true>(lds, g, S, Ee, wave);
            }
        }
        SEAM(p0 + 1);
        if (IN(p0 + 2)) { PH_TID();
            {   pg8::StaticOrder S; S.init(T, 1280, G, bid); EpiL2 El{DA, Y, A.in[lnd(I_W0)] + (size_t)l * 512, A.in[lnd(I_A0)] + (size_t)l * 512};
                pg8::gemm_phase<EpiL2, pg8::StaticOrder, true, true>(lds, pg8::mk_gemm(LA, WL2, T, 1280, 512), S, El, wave); }
            if (bid >= G - 64) s5_carry(E, X2, LB, lds, bid - (G - 64), tid);
            __syncthreads();
            fft_step3(FM, Y, lds, tid, bid, G);
        }
        SEAM(p0 + 2);
        if (IN(p0 + 3)) { PH_TID();
            rwkv_phase1(A, ws_, l, lds, wave, lane, bid, G);
            __syncthreads();
            {
                pg8::Gemm g = pg8::mk_gemm(Pu, S5Y, 1024, 4096, 512); g.a_rs = 8192; g.a_k16 = 512; g.a_kstep = 2048; g.a_pn = 32; g.ksplit = 4; g.a_delta = (long)((const char*)X2 - (const char*)Pu) - 4 * 2048;
                pg8::StaticOrder S; S.init(1024, 4096, G, bid); EpiS5Y Ey{YA};
                pg8::gemm_phase<EpiS5Y, pg8::StaticOrder, false, true, true>(lds, g, S, Ey, wave);
            }
        }
        SEAM(p0 + 3);
        if (IN(p0 + 4)) { PH_TID();
            if (bid < 64) rwkv_carry(A, ws_, lds, tid, wave, lane, bid);
            else { pg8::StaticOrder S; S.init(T, 256, G, bid < 128 ? bid - 64 : (1 << 24)); EpiGLU Eg{YA, Y, A.in[lnd(I_GLUB)] + (size_t)l * 256};
                pg8::gemm_phase<EpiGLU, pg8::StaticOrder, false, true>(lds, pg8::mk_gemm(YA, GLU, T, 256, 256), S, Eg, wave); }
        }
        SEAM(p0 + 4);
        if (IN(p0 + 5)) { PH_TID(); rwkv_phase3(A, ws_, l, lds, wave, lane, bid, G); }
        SEAM(p0 + 5);
        if (IN(p0 + 6)) { PH_TID(); rwkv_post(A, ws_, l, lane, gw, NGW); }
        SEAM(p0 + 6);
        if (IN(p0 + 7)) { PH_TID(); pg8::StaticOrder S; S.init(T, 1024, G, bid); EpiRes Er{Hf};
            pg8::gemm_phase<EpiRes, pg8::StaticOrder, false, true>(lds, pg8::mk_gemm(Y, WOUT, T, 1024, 1280), S, Er, wave); }
        SEAM(p0 + 7);
        if (IN(p0 + 8)) { PH_TID(); for (int m = gw; m < T; m += NGW) ln_row(Hf + (size_t)m * D, A.in[lnd(I_LN1G)] + (size_t)l * D, A.in[lnd(I_LN1B)] + (size_t)l * D, Hf + (size_t)m * D, Hb + (size_t)m * D, lane); }
        SEAM(p0 + 8);
        if (IN(p0 + 9)) { PH_TID(); pg8::StaticOrder S; S.init(T, 5632, G, bid); EpiSwi Es{ACT};
            pg8::gemm_phase<EpiSwi, pg8::StaticOrder, true, true>(lds, pg8::mk_gemm(Hb, W13, T, 5632, 1024), S, Es, wave); }
        SEAM(p0 + 9);
        if (IN(p0 + 10)) { PH_TID(); pg8::StaticOrder S; S.init(T, 1024, G, bid); EpiRes Er{Hf};
            pg8::gemm_phase<EpiRes, pg8::StaticOrder, false, true>(lds, pg8::mk_gemm(ACT, W2, T, 1024, DFF), S, Er, wave); }
        SEAM(p0 + 10);
        if (IN(p0 + 11)) { PH_TID();
            for (int m = gw; m < T; m += NGW) ln_row(Hf + (size_t)m * D, A.in[lnd(I_LN2G)] + (size_t)l * D, A.in[lnd(I_LN2B)] + (size_t)l * D, Hf + (size_t)m * D, Hb + (size_t)m * D, lane);
            if (l + 1 < NL) prep_weights(A, ws_, l + 1, lds, wave, lane, gw, NGW);
        }
        SEAM(p0 + 11);
}
__global__ void __launch_bounds__(NTHR, 2) hphe_fwd(Args A) {
    __builtin_assume(__builtin_amdgcn_workitem_id_y() == 0); __builtin_assume(__builtin_amdgcn_workitem_id_z() == 0);
    extern __shared__ __attribute__((aligned(16))) unsigned char lds_raw[];
    LAS unsigned char* lds = (LAS unsigned char*)lds_raw;
    cg::grid_group grid = cg::this_grid();
    const int wave0 = __builtin_amdgcn_readfirstlane(threadIdx.x >> 6);
    const int lo = A.ph_lo, hi = A.ph_hi;
    if (threadIdx.x < 2) ((volatile LAS unsigned*)(lds + LDS_BAR_OFF))[threadIdx.x] = 0u;
    __syncthreads();
    (void)xcd_barrier_post((unsigned*)(A.ws + CTL_BAR_BYTE), (volatile LAS unsigned*)(lds + LDS_BAR_OFF), threadIdx.x == 0);
    if (PROBE_MASK != 0u && blockIdx.x == 0 && threadIdx.x == 0) { PROBE_SLOT(0) = __builtin_amdgcn_s_memrealtime(); PROBE_SLOT(1) = 0ull; }

    if (IN(0)) { PH_TID();
        for (int m = gw; m < T; m += NGW) ln_row(A.in[lnd(I_X)] + (size_t)m * D, A.in[lnd(I_LN0G)], A.in[lnd(I_LN0B)], Hf + (size_t)m * D, Hb + (size_t)m * D, lane);
        prep_weights(A, ws_, 0, lds, wave, lane, gw, NGW);
    }
    SEAM(0);
    layer_body<0>(A, lds, grid, wave0, lo, hi);
    layer_body<1>(A, lds, grid, wave0, lo, hi);
    static_assert(NL == 2, "two layers instantiated");
    if (PROBE_MASK != 0u && blockIdx.x == 0 && wave0 == 0 && __builtin_amdgcn_mbcnt_hi(~0u, __builtin_amdgcn_mbcnt_lo(~0u, 0u)) == 0) { const unsigned long long t0_ = __builtin_amdgcn_s_memrealtime(), w_ = PROBE_K * PROBE_SLOT(1); while (__builtin_amdgcn_s_memrealtime() - t0_ < w_) __builtin_amdgcn_s_sleep(8); }
#undef IN
#undef SEAM
}

#ifndef MK_MULTI
#define MK_MULTI 0
#endif
extern "C" void kernel_launch(void* const* d_in, const int* in_sizes, int n_in, void* d_out, int out_size, void* d_ws, size_t ws_size, hipStream_t stream) {
    static int grid = 0;
    if (grid == 0) {
        if (n_in != N_IN || out_size != T * D || ws_size < WS_END) { fprintf(stderr, "kernel_launch: unexpected problem shape (n_in %d out %d ws %zu)\n", n_in, out_size, ws_size); grid = -1; return; }
        int dev = 0, cus = 0, per_cu = 0;
        hipGetDevice(&dev); hipDeviceGetAttribute(&cus, hipDeviceAttributeMultiprocessorCount, dev);
        hipFuncSetAttribute((const void*)hphe_fwd, hipFuncAttributeMaxDynamicSharedMemorySize, LDS_BYTES);
        hipOccupancyMaxActiveBlocksPerMultiprocessor(&per_cu, (const void*)hphe_fwd, NTHR, LDS_BYTES);
        (void)hipGetLastError();
        if (per_cu < 1) { fprintf(stderr, "kernel_launch: occupancy query says 0 blocks per CU\n"); grid = -1; return; }
        grid = cus;
    }
    if (grid < 0) return;
    if (hipMemsetAsync(d_ws, 0, 65536, stream) != hipSuccess) { fprintf(stderr, "kernel_launch: memset of the control words failed\n"); return; }
    Args a{};
    for (int i = 0; i < N_IN; ++i) a.in[i] = (const float*)d_in[i];
    a.out = (float*)d_out; a.ws = (unsigned char*)d_ws;
#if MK_MULTI
    for (int p = 0; p < N_PHASES; ++p) { a.ph_lo = p; a.ph_hi = p + 1; hipLaunchKernelGGL(hphe_fwd, dim3(grid), dim3(NTHR), LDS_BYTES, stream, a); }
#else
    a.ph_lo = 0; a.ph_hi = N_PHASES;
    void* args[] = {&a};
    hipError_t e = hipLaunchCooperativeKernel((const void*)hphe_fwd, dim3(grid), dim3(NTHR), args, LDS_BYTES, stream);
    if (e != hipSuccess) fprintf(stderr, "cooperative launch failed: %s (grid %d)\n", hipGetErrorString(e), grid);
#endif
}
```
